# Optimizing an MI355X kernel written in HIP

```python
import math
import jax, jax.numpy as jnp
from jax import lax
import numpy as np

D_MODEL = 1024
BATCH = 8
SEQ = 2048
DEPTH = 2

CHUNK = 64
Q_BLOCK = 128
EPS = 1e-6
N_A = (DEPTH + 1) // 2
N_B = DEPTH - N_A
D_FF = 2816
S5_GROUP = 16
S5_GROUPS = D_MODEL // S5_GROUP
S5_STATE = 64
S5_DT_MIN = 1e-3
S5_DT_MAX = 1e-1
MLA_HEADS = 8
NOPE_DIM = 128
ROPE_DIM = 64
V_DIM = 128
Q_LORA = 256
KV_LORA = 128
ROPE_BASE = 10000.0

kernel_name = "yoco_s5_mla_macaron_trunk"


def rms_norm(x, g):
    xf = x.astype(jnp.float32)
    y = xf * lax.rsqrt(jnp.mean(xf * xf, axis=-1, keepdims=True) + EPS)
    return (y * g.astype(jnp.float32)).astype(x.dtype)


def swiglu(h, w_in, w_out):
    gu = h @ w_in
    gate, up = gu[..., :D_FF], gu[..., D_FF:]
    return (jax.nn.silu(gate) * up) @ w_out


def rope_tables(positions):
    inv_freq = 1.0 / (ROPE_BASE ** (jnp.arange(0, ROPE_DIM, 2, dtype=jnp.float32) / ROPE_DIM))
    ang = positions.astype(jnp.float32)[..., None] * inv_freq
    return jnp.cos(ang), jnp.sin(ang)


def apply_rope(x, cos, sin):
    half = ROPE_DIM // 2
    xf = x.astype(jnp.float32)
    x1, x2 = xf[..., :half], xf[..., half:]
    return jnp.concatenate([x1 * cos - x2 * sin, x1 * sin + x2 * cos], axis=-1).astype(x.dtype)


def s5_mixer(h, lam_re, lam_im, log_step, b_re, b_im, c_re, c_im, d_skip, w_glu):
    bsz, seq, _ = h.shape
    f32 = jnp.float32
    u = h.astype(f32).reshape(bsz, seq, S5_GROUPS, S5_GROUP)
    step = jnp.exp(log_step.astype(f32))[:, None]
    lam = lax.complex(lam_re.astype(f32), lam_im.astype(f32))
    lam_bar = jnp.exp(lam * step)
    b = lax.complex(b_re.astype(f32), b_im.astype(f32))
    b_bar = ((lam_bar - 1.0) / lam)[..., None] * b
    bu = lax.complex(jnp.einsum('gpc,bsgc->bsgp', jnp.real(b_bar), u),
                     jnp.einsum('gpc,bsgc->bsgp', jnp.imag(b_bar), u))
    a = jnp.broadcast_to(lam_bar[None, None], (1, seq, S5_GROUPS, S5_STATE))

    def combine(e1, e2):
        a1, b1 = e1
        a2, b2 = e2
        return a1 * a2, a2 * b1 + b2

    _, states = lax.associative_scan(combine, (a, bu), axis=1)
    y = (jnp.einsum('gcp,bsgp->bsgc', c_re.astype(f32), jnp.real(states))
         - jnp.einsum('gcp,bsgp->bsgc', c_im.astype(f32), jnp.imag(states)))
    y = y.reshape(bsz, seq, D_MODEL) + d_skip.astype(f32) * h.astype(f32)
    y = jax.nn.gelu(y).astype(h.dtype)
    z = y @ w_glu
    return z[..., :D_MODEL] * jax.nn.sigmoid(z[..., D_MODEL:])


def shared_kv(h, cos, sin, kv_in_norm, w_dkv, kv_latent_norm, w_ukv):
    bsz, seq, _ = h.shape
    kv_a = rms_norm(h, kv_in_norm) @ w_dkv
    c_kv = rms_norm(kv_a[..., :KV_LORA], kv_latent_norm)
    k_rope = apply_rope(kv_a[..., KV_LORA:], cos, sin)
    kv = (c_kv @ w_ukv).reshape(bsz, seq, MLA_HEADS, NOPE_DIM + V_DIM)
    k_nope, v = kv[..., :NOPE_DIM], kv[..., NOPE_DIM:]
    k_rope_h = jnp.broadcast_to(k_rope[:, :, None, :], (bsz, seq, MLA_HEADS, ROPE_DIM))
    k = jnp.concatenate([k_nope, k_rope_h], axis=-1)
    return k, v


def mla_attention(h, cos, sin, k, v, w_dq, q_norm, w_uq, w_o):
    bsz, seq, _ = h.shape
    qk_dim = NOPE_DIM + ROPE_DIM
    c_q = rms_norm(h @ w_dq, q_norm)
    q = (c_q @ w_uq).reshape(bsz, seq, MLA_HEADS, qk_dim)
    q = jnp.concatenate([q[..., :NOPE_DIM],
                         apply_rope(q[..., NOPE_DIM:], cos[:, :, None, :], sin[:, :, None, :])], axis=-1)
    scale = 1.0 / math.sqrt(qk_dim)
    n_blk = seq // Q_BLOCK
    q_blocks = q.reshape(bsz, n_blk, Q_BLOCK, MLA_HEADS, qk_dim).transpose(1, 0, 2, 3, 4)
    q_chunk = (jnp.arange(seq, dtype=jnp.int32) // CHUNK).reshape(n_blk, Q_BLOCK)
    k_chunk = jnp.arange(seq, dtype=jnp.int32) // CHUNK
    neg = jnp.finfo(jnp.float32).min

    def attend(args):
        qb, qc = args
        s = jnp.einsum('bqhd,bkhd->bhqk', qb, k).astype(jnp.float32) * scale
        mask = k_chunk[None, :] <= qc[:, None]
        s = jnp.where(mask[None, None], s, neg)
        p = jax.nn.softmax(s, axis=-1).astype(v.dtype)
        return jnp.einsum('bhqk,bkhd->bqhd', p, v)

    o = lax.map(attend, (q_blocks, q_chunk))
    o = o.transpose(1, 0, 2, 3, 4).reshape(bsz, seq, MLA_HEADS * V_DIM)
    return o @ w_o


def setup_inputs(seed: int = 0) -> dict:
    key = jax.random.key(seed)
    ks = jax.random.split(key, 24)
    f32 = jnp.float32

    def nrm(k, shape, fan_in):
        return jax.random.normal(k, shape, f32) * (fan_in ** -0.5)

    def gain(k, shape):
        return 1.0 + 0.02 * jax.random.normal(k, shape, f32)

    x = jax.random.normal(ks[0], (BATCH, SEQ, D_MODEL), f32)
    start = jax.random.randint(ks[1], (BATCH, 1), 0, 4096, dtype=jnp.int32)
    positions = (start + jnp.arange(SEQ, dtype=jnp.int32)[None, :]).astype(jnp.int32)
    norm_gains = gain(ks[2], (DEPTH, 3, D_MODEL))
    ffn_w_in = nrm(ks[3], (DEPTH, 2, D_MODEL, 2 * D_FF), D_MODEL)
    ffn_w_out = nrm(ks[4], (DEPTH, 2, D_FF, D_MODEL), D_FF)
    n_idx = jnp.arange(S5_STATE, dtype=f32)
    s5_lambda_re = -0.5 * jnp.exp(0.05 * jax.random.normal(ks[5], (N_A, S5_GROUPS, S5_STATE), f32))
    s5_lambda_im = math.pi * n_idx + 0.05 * jax.random.normal(ks[6], (N_A, S5_GROUPS, S5_STATE), f32)
    s5_log_step = jax.random.uniform(ks[7], (N_A, S5_GROUPS), f32,
                                     math.log(S5_DT_MIN), math.log(S5_DT_MAX))
    s5_b_re = nrm(ks[8], (N_A, S5_GROUPS, S5_STATE, S5_GROUP), 2 * S5_GROUP)
    s5_b_im = nrm(ks[9], (N_A, S5_GROUPS, S5_STATE, S5_GROUP), 2 * S5_GROUP)
    s5_c_re = nrm(ks[10], (N_A, S5_GROUPS, S5_GROUP, S5_STATE), S5_STATE)
    s5_c_im = nrm(ks[11], (N_A, S5_GROUPS, S5_GROUP, S5_STATE), S5_STATE)
    s5_d = jax.random.normal(ks[12], (N_A, D_MODEL), f32)
    s5_w_glu = nrm(ks[13], (N_A, D_MODEL, 2 * D_MODEL), D_MODEL)
    kv_in_norm = gain(ks[14], (D_MODEL,))
    w_dkv = nrm(ks[15], (D_MODEL, KV_LORA + ROPE_DIM), D_MODEL)
    kv_latent_norm = gain(ks[16], (KV_LORA,))
    w_ukv = nrm(ks[17], (KV_LORA, MLA_HEADS * (NOPE_DIM + V_DIM)), KV_LORA)
    mla_w_dq = nrm(ks[18], (N_B, D_MODEL, Q_LORA), D_MODEL)
    mla_q_norm = gain(ks[19], (N_B, Q_LORA))
    mla_w_uq = nrm(ks[20], (N_B, Q_LORA, MLA_HEADS * (NOPE_DIM + ROPE_DIM)), Q_LORA)
    mla_w_o = nrm(ks[21], (N_B, MLA_HEADS * V_DIM, D_MODEL), MLA_HEADS * V_DIM)
    final_norm = gain(ks[22], (D_MODEL,))
    return {"x": x, "positions": positions, "norm_gains": norm_gains,
            "ffn_w_in": ffn_w_in, "ffn_w_out": ffn_w_out,
            "s5_lambda_re": s5_lambda_re, "s5_lambda_im": s5_lambda_im,
            "s5_log_step": s5_log_step, "s5_b_re": s5_b_re, "s5_b_im": s5_b_im,
            "s5_c_re": s5_c_re, "s5_c_im": s5_c_im, "s5_d": s5_d, "s5_w_glu": s5_w_glu,
            "kv_in_norm": kv_in_norm, "w_dkv": w_dkv, "kv_latent_norm": kv_latent_norm,
            "w_ukv": w_ukv, "mla_w_dq": mla_w_dq, "mla_q_norm": mla_q_norm,
            "mla_w_uq": mla_w_uq, "mla_w_o": mla_w_o, "final_norm": final_norm}


def reference(x, positions, norm_gains, ffn_w_in, ffn_w_out,
              s5_lambda_re, s5_lambda_im, s5_log_step, s5_b_re, s5_b_im,
              s5_c_re, s5_c_im, s5_d, s5_w_glu,
              kv_in_norm, w_dkv, kv_latent_norm, w_ukv,
              mla_w_dq, mla_q_norm, mla_w_uq, mla_w_o, final_norm):
    cos, sin = rope_tables(positions)
    k_shared = None
    v_shared = None
    for l in range(DEPTH):
        g = norm_gains[l]
        x = x + 0.5 * swiglu(rms_norm(x, g[0]), ffn_w_in[l, 0], ffn_w_out[l, 0])
        h = rms_norm(x, g[1])
        if l < N_A:
            x = x + s5_mixer(h, s5_lambda_re[l], s5_lambda_im[l], s5_log_step[l],
                             s5_b_re[l], s5_b_im[l], s5_c_re[l], s5_c_im[l],
                             s5_d[l], s5_w_glu[l])
        else:
            j = l - N_A
            x = x + mla_attention(h, cos, sin, k_shared, v_shared,
                                  mla_w_dq[j], mla_q_norm[j], mla_w_uq[j], mla_w_o[j])
        x = x + 0.5 * swiglu(rms_norm(x, g[2]), ffn_w_in[l, 1], ffn_w_out[l, 1])
        if l == N_A - 1 and N_B > 0:
            k_shared, v_shared = shared_kv(x, cos, sin, kv_in_norm, w_dkv,
                                           kv_latent_norm, w_ukv)
    return rms_norm(x, final_norm)
```

```cpp
#include <hip/hip_runtime.h>
#include <cstdio>
#include <cstdint>
#include <cmath>

namespace nv {
constexpr int B_ = 8, S_ = 2048, D_ = 1024, M_ = B_ * S_, FF_ = 2816, G_ = 64, P_ = 64, H_ = 8;
constexpr float EPS_ = 1e-6f;

__device__ __forceinline__ float wsum(float v) {
#pragma unroll
    for (int o = 1; o < 64; o <<= 1) v += __shfl_xor(v, o);
    return v;
}
__device__ __forceinline__ float wmax(float v) {
#pragma unroll
    for (int o = 1; o < 64; o <<= 1) v = fmaxf(v, __shfl_xor(v, o));
    return v;
}
__device__ __forceinline__ float gelu_tanh(float x) {
    const float k0 = 0.7978845608028654f, k1 = 0.044715f;
    return 0.5f * x * (1.f + tanhf(k0 * (x + k1 * x * x * x)));
}
__device__ __forceinline__ float sigmoidf_(float x) { return 1.f / (1.f + expf(-x)); }

__global__ __launch_bounds__(256) void rmsnorm(const float* x, int ldx, const float* g, float* out, int ldo, int rows, int cols) {
    const int w = threadIdx.x >> 6, lane = threadIdx.x & 63;
    const int row = blockIdx.x * 4 + w;
    if (row >= rows) return;
    const float* xr = x + (size_t)row * ldx;
    float s = 0.f;
    for (int c = lane; c < cols; c += 64) { float v = xr[c]; s += v * v; }
    s = wsum(s);
    const float r = rsqrtf(s / (float)cols + EPS_);
    float* o = out + (size_t)row * ldo;
    for (int c = lane; c < cols; c += 64) o[c] = xr[c] * r * g[c];
}

template <int MODE>
__global__ __launch_bounds__(256) void gemm(const float* A, int lda, const float* B, int ldb, float* C, int ldc, int M, int N, int K, float alpha, int b2off) {
    constexpr bool DUAL = (MODE == 1 || MODE == 3);
    __shared__ float As[8][128 + 4];
    __shared__ float Bs[8][128];
    __shared__ float Bs2[DUAL ? 8 : 1][128];
    const int tid = threadIdx.x, tx = tid & 15, ty = tid >> 4;
    const int row0 = blockIdx.y * 128, col0 = blockIdx.x * 128;
    float acc[8][8], acc2[DUAL ? 8 : 1][8];
#pragma unroll
    for (int i = 0; i < 8; ++i)
#pragma unroll
        for (int j = 0; j < 8; ++j) { acc[i][j] = 0.f; if (DUAL) acc2[i][j] = 0.f; }
    for (int k0 = 0; k0 < K; k0 += 8) {
        { const int r = tid >> 1, kk = (tid & 1) * 4;
          const float4 v = *(const float4*)(A + (size_t)(row0 + r) * lda + k0 + kk);
          As[kk + 0][r] = v.x; As[kk + 1][r] = v.y; As[kk + 2][r] = v.z; As[kk + 3][r] = v.w; }
        { const int kk = tid >> 5, n = (tid & 31) * 4;
          float4 v = {0.f, 0.f, 0.f, 0.f};
          if (col0 + n < N) v = *(const float4*)(B + (size_t)(k0 + kk) * ldb + col0 + n);
          *(float4*)&Bs[kk][n] = v;
          if (DUAL) { float4 v2 = {0.f, 0.f, 0.f, 0.f};
              if (col0 + n < N) v2 = *(const float4*)(B + (size_t)(k0 + kk) * ldb + b2off + col0 + n);
              *(float4*)&Bs2[kk][n] = v2; } }
        __syncthreads();
#pragma unroll
        for (int kk = 0; kk < 8; ++kk) {
            float a[8], b[8];
#pragma unroll
            for (int i = 0; i < 8; ++i) a[i] = As[kk][ty * 8 + i];
#pragma unroll
            for (int j = 0; j < 8; ++j) b[j] = Bs[kk][tx * 8 + j];
#pragma unroll
            for (int i = 0; i < 8; ++i)
#pragma unroll
                for (int j = 0; j < 8; ++j) acc[i][j] += a[i] * b[j];
            if (DUAL) {
                float b2[8];
#pragma unroll
                for (int j = 0; j < 8; ++j) b2[j] = Bs2[kk][tx * 8 + j];
#pragma unroll
                for (int i = 0; i < 8; ++i)
#pragma unroll
                    for (int j = 0; j < 8; ++j) acc2[i][j] += a[i] * b2[j];
            }
        }
        __syncthreads();
    }
#pragma unroll
    for (int i = 0; i < 8; ++i) {
        const int r = row0 + ty * 8 + i;
#pragma unroll
        for (int j = 0; j < 8; ++j) {
            const int c = col0 + tx * 8 + j;
            if (c < N) {
                float* p = C + (size_t)r * ldc + c;
                if (MODE == 0) *p = acc[i][j];
                else if (MODE == 1) { const float gte = acc[i][j]; *p = gte * sigmoidf_(gte) * acc2[i][j]; }
                else if (MODE == 2) *p += alpha * acc[i][j];
                else *p += acc[i][j] * sigmoidf_(acc2[i][j]);
            }
        }
    }
}

__global__ __launch_bounds__(64) void s5(const float* h, const float* lam_re, const float* lam_im, const float* log_step,
                                         const float* b_re, const float* b_im, const float* c_re, const float* c_im,
                                         const float* d_skip, float* y) {
    const int g = blockIdx.x % G_, b = blockIdx.x / G_, p = threadIdx.x;
    __shared__ float su[16];
    __shared__ float sx[128];
    __shared__ float scr[16][64];
    __shared__ float sci[16][64];
    for (int i = p; i < 16 * 64; i += 64) { scr[i / 64][i % 64] = c_re[(size_t)g * 1024 + i]; sci[i / 64][i % 64] = c_im[(size_t)g * 1024 + i]; }
    const float step = expf(log_step[g]);
    const float lr = lam_re[g * 64 + p], li = lam_im[g * 64 + p];
    const float er = expf(lr * step), ang = li * step;
    const float lbr = er * cosf(ang), lbi = er * sinf(ang);
    const float nr = lbr - 1.f, ni = lbi, den = lr * lr + li * li;
    const float cr = (nr * lr + ni * li) / den, ci = (ni * lr - nr * li) / den;
    float bbr[16], bbi[16];
#pragma unroll
    for (int i = 0; i < 16; ++i) {
        const float br = b_re[((size_t)g * 64 + p) * 16 + i], bi = b_im[((size_t)g * 64 + p) * 16 + i];
        bbr[i] = cr * br - ci * bi; bbi[i] = cr * bi + ci * br;
    }
    const float dsk = (p < 16) ? d_skip[g * 16 + p] : 0.f;
    float xr = 0.f, xi = 0.f;
    __syncthreads();
    for (int t = 0; t < S_; ++t) {
        const size_t tok = (size_t)b * S_ + t;
        if (p < 16) su[p] = h[tok * D_ + g * 16 + p];
        __syncthreads();
        float bur = 0.f, bui = 0.f;
#pragma unroll
        for (int i = 0; i < 16; ++i) { bur += bbr[i] * su[i]; bui += bbi[i] * su[i]; }
        const float nxr = lbr * xr - lbi * xi + bur, nxi = lbr * xi + lbi * xr + bui;
        xr = nxr; xi = nxi;
        sx[p] = xr; sx[64 + p] = xi;
        __syncthreads();
        if (p < 16) {
            float a = 0.f;
            for (int q = 0; q < 64; ++q) a += scr[p][q] * sx[q] - sci[p][q] * sx[64 + q];
            y[tok * D_ + g * 16 + p] = gelu_tanh(a + dsk * su[p]);
        }
    }
}

__global__ __launch_bounds__(256) void kv_post(const float* kva, const float* g, const int* pos, float* ckv, float* Kb) {
    const int w = threadIdx.x >> 6, lane = threadIdx.x & 63;
    const int m = blockIdx.x * 4 + w;
    const float* r = kva + (size_t)m * 192;
    const float v0 = r[lane], v1 = r[64 + lane];
    const float ss = wsum(v0 * v0 + v1 * v1);
    const float rs = rsqrtf(ss / 128.f + EPS_);
    ckv[(size_t)m * 128 + lane] = v0 * rs * g[lane];
    ckv[(size_t)m * 128 + 64 + lane] = v1 * rs * g[64 + lane];
    if (lane < 32) {
        const float invf = 1.0f / powf(10000.0f, (float)(2 * lane) / 64.0f);
        const float ang = (float)pos[m] * invf;
        const float c = cosf(ang), s = sinf(ang);
        const float x1 = r[128 + lane], x2 = r[160 + lane];
        const float o1 = x1 * c - x2 * s, o2 = x1 * s + x2 * c;
        for (int hh = 0; hh < H_; ++hh) { Kb[((size_t)m * H_ + hh) * 192 + 128 + lane] = o1; Kb[((size_t)m * H_ + hh) * 192 + 160 + lane] = o2; }
    }
}
__global__ __launch_bounds__(256) void kv_scatter(const float* kv, float* Kb, float* Vb) {
    const size_t i = (size_t)blockIdx.x * 256 + threadIdx.x;
    const int c = (int)(i & 255); const size_t mh = i >> 8;
    const float v = kv[i];
    if (c < 128) Kb[mh * 192 + c] = v; else Vb[mh * 128 + (c - 128)] = v;
}
__global__ __launch_bounds__(256) void rope_q(float* q, const int* pos) {
    const size_t i = (size_t)blockIdx.x * 256 + threadIdx.x;
    const int j = (int)(i & 31); const size_t mh = i >> 5; const size_t m = mh >> 3;
    const float invf = 1.0f / powf(10000.0f, (float)(2 * j) / 64.0f);
    const float ang = (float)pos[m] * invf;
    const float c = cosf(ang), s = sinf(ang);
    float* p = q + mh * 192 + 128;
    const float x1 = p[j], x2 = p[32 + j];
    p[j] = x1 * c - x2 * s; p[32 + j] = x1 * s + x2 * c;
}
__global__ __launch_bounds__(256) void attn(const float* Q, const float* K, const float* V, float* O) {
    __shared__ float sp[4][2048];
    __shared__ float sq[4][192];
    const int w = threadIdx.x >> 6, lane = threadIdx.x & 63;
    const size_t gw = (size_t)blockIdx.x * 4 + w;
    const int hh = (int)(gw & 7); const size_t m = gw >> 3; const int b = (int)(m / S_), s = (int)(m % S_);
    const int nk = ((s >> 6) + 1) * 64;
    const float scale = 0.07216878364870323f;
    const float* qp = Q + (m * H_ + hh) * 192;
    sq[w][lane] = qp[lane]; sq[w][64 + lane] = qp[64 + lane]; sq[w][128 + lane] = qp[128 + lane];
    __syncthreads();
    float mx = -INFINITY;
    for (int k0 = 0; k0 < nk; k0 += 64) {
        const int key = k0 + lane;
        const float* kp = K + (((size_t)b * S_ + key) * H_ + hh) * 192;
        float d = 0.f;
        for (int c = 0; c < 192; c += 4) { const float4 kv4 = *(const float4*)(kp + c); d += sq[w][c] * kv4.x + sq[w][c + 1] * kv4.y + sq[w][c + 2] * kv4.z + sq[w][c + 3] * kv4.w; }
        d *= scale; sp[w][key] = d; mx = fmaxf(mx, d);
    }
    mx = wmax(mx);
    __syncthreads();
    float sum = 0.f;
    for (int k = lane; k < nk; k += 64) { const float e = expf(sp[w][k] - mx); sp[w][k] = e; sum += e; }
    sum = wsum(sum);
    __syncthreads();
    float o0 = 0.f, o1 = 0.f;
    for (int k = 0; k < nk; ++k) {
        const float pk = sp[w][k];
        const float* vp = V + (((size_t)b * S_ + k) * H_ + hh) * 128;
        o0 += pk * vp[lane]; o1 += pk * vp[64 + lane];
    }
    const float inv = 1.f / sum;
    O[m * D_ + hh * 128 + lane] = o0 * inv; O[m * D_ + hh * 128 + 64 + lane] = o1 * inv;
}
}

extern "C" void kernel_launch(void* const* d_in, const int* in_sizes, int n_in, void* d_out, int out_size, void* d_ws, size_t ws_size, hipStream_t stream) {
    using namespace nv;
    const float* x_in = (const float*)d_in[0]; const int* pos = (const int*)d_in[1];
    const float* gains = (const float*)d_in[2]; const float* w_in = (const float*)d_in[3]; const float* w_out = (const float*)d_in[4];
    const float* lam_re = (const float*)d_in[5]; const float* lam_im = (const float*)d_in[6]; const float* log_step = (const float*)d_in[7];
    const float* b_re = (const float*)d_in[8]; const float* b_im = (const float*)d_in[9]; const float* c_re = (const float*)d_in[10]; const float* c_im = (const float*)d_in[11];
    const float* s5_d = (const float*)d_in[12]; const float* w_glu = (const float*)d_in[13]; const float* kv_in_norm = (const float*)d_in[14];
    const float* w_dkv = (const float*)d_in[15]; const float* kv_lat_norm = (const float*)d_in[16]; const float* w_ukv = (const float*)d_in[17];
    const float* w_dq = (const float*)d_in[18]; const float* q_norm = (const float*)d_in[19]; const float* w_uq = (const float*)d_in[20];
    const float* w_o = (const float*)d_in[21]; const float* final_norm = (const float*)d_in[22];
    float* x = (float*)d_out;
    char* ws = (char*)d_ws;
    constexpr size_t MiB = 1u << 20;
    if (ws_size < 352 * MiB) { fprintf(stderr, "ws too small: %zu\n", ws_size); return; }
    float* Kb = (float*)(ws);
    float* Vb = (float*)(ws + 96 * MiB);
    float* hb = (float*)(ws + 160 * MiB);
    float* act = (float*)(ws + 224 * MiB);
    float* Qb = (float*)(ws + 224 * MiB);
    float* yb = (float*)(ws + 224 * MiB);
    float* kvt = (float*)(ws + 160 * MiB);
    float* kva = (float*)(ws + 320 * MiB);
    float* ckv = (float*)(ws + 332 * MiB);
    float* cqr = (float*)(ws + 320 * MiB);
    float* cq = (float*)(ws + 336 * MiB);

    hipMemcpyAsync(x, x_in, (size_t)M_ * D_ * 4, hipMemcpyDeviceToDevice, stream);
    auto ffn = [&](int l, int j) {
        const float* g = gains + (size_t)(l * 3 + (j == 0 ? 0 : 2)) * D_;
        const float* wi = w_in + (size_t)(l * 2 + j) * D_ * 2 * FF_; const float* wo = w_out + (size_t)(l * 2 + j) * FF_ * D_;
        rmsnorm<<<M_ / 4, 256, 0, stream>>>(x, D_, g, hb, D_, M_, D_);
        for (int half = 0; half < 2; ++half) {
            const size_t r0 = (size_t)half * (M_ / 2);
            gemm<1><<<dim3(FF_ / 128, M_ / 2 / 128), 256, 0, stream>>>(hb + r0 * D_, D_, wi, 2 * FF_, act, FF_, M_ / 2, FF_, D_, 0.f, FF_);
            gemm<2><<<dim3(D_ / 128, M_ / 2 / 128), 256, 0, stream>>>(act, FF_, wo, D_, x + r0 * D_, D_, M_ / 2, D_, FF_, 0.5f, 0);
        }
    };
    ffn(0, 0);
    rmsnorm<<<M_ / 4, 256, 0, stream>>>(x, D_, gains + 1 * D_, hb, D_, M_, D_);
    s5<<<B_ * G_, 64, 0, stream>>>(hb, lam_re, lam_im, log_step, b_re, b_im, c_re, c_im, s5_d, yb);
    gemm<3><<<dim3(D_ / 128, M_ / 128), 256, 0, stream>>>(yb, D_, w_glu, 2 * D_, x, D_, M_, D_, D_, 0.f, D_);
    ffn(0, 1);
    rmsnorm<<<M_ / 4, 256, 0, stream>>>(x, D_, kv_in_norm, hb, D_, M_, D_);
    gemm<0><<<dim3(2, M_ / 128), 256, 0, stream>>>(hb, D_, w_dkv, 192, kva, 192, M_, 192, D_, 0.f, 0);
    kv_post<<<M_ / 4, 256, 0, stream>>>(kva, kv_lat_norm, pos, ckv, Kb);
    gemm<0><<<dim3(2048 / 128, M_ / 128), 256, 0, stream>>>(ckv, 128, w_ukv, 2048, kvt, 2048, M_, 2048, 128, 0.f, 0);
    kv_scatter<<<(unsigned)((size_t)M_ * 2048 / 256), 256, 0, stream>>>(kvt, Kb, Vb);
    ffn(1, 0);
    rmsnorm<<<M_ / 4, 256, 0, stream>>>(x, D_, gains + (size_t)(3 + 1) * D_, hb, D_, M_, D_);
    gemm<0><<<dim3(256 / 128, M_ / 128), 256, 0, stream>>>(hb, D_, w_dq, 256, cqr, 256, M_, 256, D_, 0.f, 0);
    rmsnorm<<<M_ / 4, 256, 0, stream>>>(cqr, 256, q_norm, cq, 256, M_, 256);
    gemm<0><<<dim3(1536 / 128, M_ / 128), 256, 0, stream>>>(cq, 256, w_uq, 1536, Qb, 1536, M_, 1536, 256, 0.f, 0);
    rope_q<<<(unsigned)((size_t)M_ * 8 * 32 / 256), 256, 0, stream>>>(Qb, pos);
    attn<<<(unsigned)((size_t)M_ * 8 / 4), 256, 0, stream>>>(Qb, Kb, Vb, hb);
    gemm<2><<<dim3(D_ / 128, M_ / 128), 256, 0, stream>>>(hb, D_, w_o, D_, x, D_, M_, D_, D_, 1.0f, 0);
    ffn(1, 1);
    rmsnorm<<<M_ / 4, 256, 0, stream>>>(x, D_, final_norm, x, D_, M_, D_);
}
```

```cpp
#include <hip/hip_runtime.h>
#include <hip/hip_bf16.h>
#include <cstdio>
#include <cstdint>
#include <cmath>

#ifndef MK_MODE
#define MK_MODE 0
#endif
#ifndef MK_CUT_LO
#define MK_CUT_LO 0
#define MK_CUT_HI 2
#endif

constexpr int BATCH = 8, SEQ = 2048, D = 1024, M = BATCH * SEQ, FF = 2816, NG = 64, NP = 64, NH = 8;
constexpr float EPS = 1e-6f;
constexpr float QSCALE = 0.07216878364870323f * 1.4426950408889634f;
constexpr int NWAVES = 8;
constexpr int P256 = 320;

constexpr size_t MiB = 1u << 20;
constexpr size_t WS_CTL = 0, CTL_ZERO_BYTES = 65536;
constexpr size_t WS_RSS = 1 * MiB;
constexpr size_t WS_WIN = 2 * MiB;
constexpr size_t WIN_BYTES = (size_t)2 * FF * D * 2;
constexpr size_t WS_WOUT = WS_WIN + 4 * WIN_BYTES;
constexpr size_t WOUT_BYTES = (size_t)D * FF * 2;
constexpr size_t WS_WGLU = WS_WOUT + 4 * WOUT_BYTES;
constexpr size_t WS_WDKV = WS_WGLU + (size_t)2048 * 1024 * 2;
constexpr size_t WS_WUKV = WS_WDKV + (size_t)256 * 1024 * 2;
constexpr size_t WS_WDQ = WS_WUKV + (size_t)2048 * P256 * 2;
constexpr size_t WS_WUQ = WS_WDQ + (size_t)256 * 1024 * 2;
constexpr size_t WS_WO = WS_WUQ + (size_t)1536 * P256 * 2;
constexpr size_t WS_WEND = WS_WO + (size_t)1024 * 1024 * 2;
static_assert(WS_WEND <= 78 * MiB, "weights");
constexpr size_t WS_TH = 78 * MiB;
constexpr size_t WS_GT = 90 * MiB;
constexpr size_t WS_ROPE = 98 * MiB;
constexpr size_t WS_L16 = 256 * 1024;
constexpr size_t WS_XB = 102 * MiB;
constexpr size_t WS_ACT = 134 * MiB;
constexpr size_t WS_Q = WS_ACT, WS_O = WS_ACT + 48 * MiB;
constexpr size_t WS_R2 = 222 * MiB;
constexpr size_t WS_UG = WS_R2, WS_Y = WS_R2 + 48 * MiB, WS_SEND = WS_R2 + 80 * MiB;
constexpr size_t WS_KN = WS_R2, WS_V = WS_R2 + 32 * MiB, WS_KR = WS_R2 + 64 * MiB, WS_LAT = WS_R2 + 66 * MiB, WS_CQ = WS_R2 + 78 * MiB;
constexpr size_t WS_RSP = 334 * MiB;
constexpr size_t WS_END = 342 * MiB;
static_assert(WS_ROPE + (size_t)M * 32 * 4 * 2 <= WS_XB && WS_L16 >= CTL_ZERO_BYTES && WS_L16 + 32768 <= 512 * 1024, "rope tables / l16 placement");

constexpr int CW_TMO = 0, CW_CODE = 1, CW_BAR = 4096;
enum { RS_X0 = 0, RS_X1, RS_X2, RS_X3, RS_X4, RS_X5, RS_X6, RS_LAT, RS_Q, RS_N };
__host__ __device__ constexpr int rs_slots(int id) { return id == RS_X0 ? 1 : id == RS_X2 ? 32 : (id == RS_LAT || id == RS_Q) ? 4 : 16; }
__host__ __device__ constexpr size_t rs_off(int id) { size_t o = 0; for (int i = 1; i < id; ++i) o += (size_t)M * rs_slots(i) * 4; return o; }
static_assert(rs_off(RS_N) <= 8 * MiB, "partial-sum arrays");

constexpr int RING_OFF = 0, RING_BYTES = 131072;
constexpr int LDSCTL_OFF = RING_BYTES, MISC_OFF = LDSCTL_OFF + 320;
constexpr int EPI_OFF = MISC_OFF + 128, GP_OFF = EPI_OFF + 128, PT_OFF = GP_OFF + 80;
constexpr int RSL_OFF = (PT_OFF + 24 * 8 + 15) / 16 * 16;
constexpr int LDS_BYTES = 147456;
static_assert(RSL_OFF + 8192 <= LDS_BYTES, "row-scale table");

#define GAS __attribute__((address_space(1)))
#define LAS __attribute__((address_space(3)))
typedef unsigned short bf16;
typedef unsigned v4u __attribute__((ext_vector_type(4)));
typedef unsigned v2u __attribute__((ext_vector_type(2)));
typedef float f32x4 __attribute__((ext_vector_type(4)));
typedef float f32x2 __attribute__((ext_vector_type(2)));
typedef short bf16x8 __attribute__((ext_vector_type(8)));
typedef GAS unsigned gu32;
#define RLX_AGENT __ATOMIC_RELAXED, __HIP_MEMORY_SCOPE_AGENT
#define LDS_WAIT() asm volatile("s_waitcnt lgkmcnt(0)" ::: "memory")
#define VM_WAIT() asm volatile("s_waitcnt vmcnt(0)" ::: "memory")
typedef _Float16 h16x2 __attribute__((ext_vector_type(2)));
typedef _Float16 h16x8 __attribute__((ext_vector_type(8)));
__device__ __forceinline__ unsigned f2bf(float f) { return (unsigned)__builtin_bit_cast(unsigned short, (_Float16)f); }
__device__ __forceinline__ unsigned pk2(float lo, float hi) { const h16x2 v = {(_Float16)lo, (_Float16)hi}; return __builtin_bit_cast(unsigned, v); }
__device__ __forceinline__ float bf2f(unsigned h) { return (float)__builtin_bit_cast(_Float16, (unsigned short)h); }
__device__ __forceinline__ float wave_sum(float v) {
#pragma unroll
    for (int o = 1; o < 64; o <<= 1) v += __shfl_xor(v, o);
    return v;
}


#ifdef MK_BYPASS
typedef __amdgpu_buffer_rsrc_t brs_t;
#define AUXS 17
__device__ __forceinline__ brs_t mkb(const void* p) {
    const unsigned long long v = (unsigned long long)p; const unsigned lo = __builtin_amdgcn_readfirstlane((unsigned)v), hi = __builtin_amdgcn_readfirstlane((unsigned)(v >> 32));
    return __builtin_amdgcn_make_buffer_rsrc((void*)(((unsigned long long)hi << 32) | lo), 0, 0x7fffffff, 0x00020000); }
__device__ __forceinline__ unsigned boff(const void* base, const void* p) { return (unsigned)((const char*)p - (const char*)base); }
__device__ __forceinline__ v4u gld16(const void* base, const void* p) { return __builtin_amdgcn_raw_buffer_load_b128(mkb(base), boff(base, p), 0, AUXS); }
__device__ __forceinline__ unsigned gld4(const void* base, const void* p) { return __builtin_amdgcn_raw_buffer_load_b32(mkb(base), boff(base, p), 0, AUXS); }
__device__ __forceinline__ void gst16(void* base, void* p, v4u v) { __builtin_amdgcn_raw_buffer_store_b128(v, mkb(base), boff(base, p), 0, AUXS); }
__device__ __forceinline__ void gst8(void* base, void* p, v2u v) { __builtin_amdgcn_raw_buffer_store_b64(v, mkb(base), boff(base, p), 0, AUXS); }
__device__ __forceinline__ void gst4(void* base, void* p, unsigned v) { __builtin_amdgcn_raw_buffer_store_b32(v, mkb(base), boff(base, p), 0, AUXS); }
__device__ __forceinline__ void gst2(void* base, void* p, unsigned short v) { __builtin_amdgcn_raw_buffer_store_b16(v, mkb(base), boff(base, p), 0, AUXS); }
#else
__device__ __forceinline__ v4u gld16(const void*, const void* p) { return *(const GAS v4u*)(unsigned long long)p; }
__device__ __forceinline__ unsigned gld4(const void*, const void* p) { return *(const GAS unsigned*)(unsigned long long)p; }
__device__ __forceinline__ void gst16(void*, void* p, v4u v) { *(GAS v4u*)(unsigned long long)p = v; }
__device__ __forceinline__ void gst8(void*, void* p, v2u v) { *(GAS v2u*)(unsigned long long)p = v; }
__device__ __forceinline__ void gst4(void*, void* p, unsigned v) { *(GAS unsigned*)(unsigned long long)p = v; }
__device__ __forceinline__ void gst2(void*, void* p, unsigned short v) { *(GAS unsigned short*)(unsigned long long)p = v; }
#endif
__device__ __forceinline__ f32x4 gld16f(const void* base, const void* p) { return __builtin_bit_cast(f32x4, gld16(base, p)); }
__device__ __forceinline__ float gld4f(const void* base, const void* p) { return __builtin_bit_cast(float, gld4(base, p)); }
__device__ __forceinline__ void gst16f(void* base, void* p, f32x4 v) { gst16(base, p, __builtin_bit_cast(v4u, v)); }
__device__ __forceinline__ void gst4f(void* base, void* p, float v) { gst4(base, p, __builtin_bit_cast(unsigned, v)); }

#ifdef DG_LDSDMA_AUX
#define PG8_AUX DG_LDSDMA_AUX
#else
#define PG8_AUX 0
#endif
namespace pg8 {
#define PG8_LAS __attribute__((address_space(3)))
typedef unsigned short bf16_t;
typedef short bf16x8 __attribute__((ext_vector_type(8)));
typedef float f32x4 __attribute__((ext_vector_type(4)));
typedef unsigned u32x4 __attribute__((ext_vector_type(4)));
constexpr int BM = 256, BK = 64, HALF = 128, HTB = HALF * BK * 2, STAGE_BYTES = 8 * HTB, NXCD = 8, WGM = 8;
__host__ __device__ __forceinline__ int lds_byte(int r, int c) { const int st = (r >> 4) * 2 + (c >> 5), rr = r & 15, cc = c & 31, ob = rr * 64 + cc * 2; return st * 1024 + (ob ^ (((ob >> 9) & 1) << 5)); }
__host__ __device__ __forceinline__ void stage_rc(int b, int& R, int& C) { const int st = b / 1024, sb = b % 1024, swz = sb ^ (((sb >> 9) & 1) << 5); R = (st >> 1) * 16 + swz / 64; C = (st & 1) * 32 + (swz % 64) / 2; }
__host__ __device__ __forceinline__ int perm32(int rho) { const int n = rho >> 4, i = rho & 15; return 8 * (i >> 2) + 4 * n + (i & 3); }
struct Unit { int pm, pn; };
struct Gemm { const bf16_t* A; const bf16_t* Bt; int lda, ldb, K, bgt; size_t bgbytes; };
struct StaticOrder {
    int nM, nN, nwg, G, c;
    __host__ __device__ void init(int M_, int N_, int G_, int c_) { nM = M_ / BM; nN = N_ / BM; nwg = nM * nN; G = G_; c = c_; }
    __host__ __device__ bool next(int i, Unit& u) const {
        const long L = (long)i * G + c; if (L >= nwg) return false;
        int wgid = (int)L; { const int q = nwg / NXCD, r = nwg % NXCD, xcd = wgid % NXCD, off = wgid / NXCD; wgid = (xcd < r ? xcd * (q + 1) : r * (q + 1) + (xcd - r) * q) + off; }
        const int nig = WGM * nN, gid = wgid / nig, fm = gid * WGM, gsz = (nM - fm) < WGM ? (nM - fm) : WGM;
        u.pm = fm + ((wgid % nig) % gsz); u.pn = (wgid % nig) / gsz; return true;
    }
    __device__ __forceinline__ void a_ready(const Unit&) const {}
    __device__ __forceinline__ void done(const Unit&) const {}
};
__device__ __forceinline__ unsigned cvt_pk_bf16(float lo, float hi) { return pk2(lo, hi); }

enum EpiMode { EM_SWIGLU = 0, EM_RES, EM_GLU, EM_DKV, EM_UKV, EM_DQ, EM_UQ, EM_SEND, EM_Y };
__device__ __forceinline__ float fast_sigmoid(float x) { return __builtin_amdgcn_rcpf(1.f + __builtin_amdgcn_exp2f(-1.4426950408889634f * x)); }
__device__ __forceinline__ float gelu_tanh_f(float x) {
    const float u = 0.7978845608028654f * (x + 0.044715f * x * x * x);
    return x * fast_sigmoid(2.f * u);
}
struct EpiParams {
    int mode; float inv_k; float alpha; int ldo; int rss_n; int rs_lds;
    const float* rss_in;
    float* rss_out;
    const float* base; float* out;
    bf16_t* ob;
    bf16_t* ob2;
    const float* aux0; const float* aux1;
    const bf16_t* ua;
    float* fout;
};
struct EpiDyn {
    static constexpr bool PERM = true, AFTER_DRAIN = false;
    const PG8_LAS EpiParams* P;
    __device__ __forceinline__ void operator()(const f32x4 (&acc)[2][2][4][2], const Unit& u, int wr, int wc, int fr, int fq) const {
        const int mode = P->mode; const float inv_k = P->inv_k, alpha = P->alpha; const int ldo = P->ldo, rss_n = P->rss_n, rs_lds = P->rs_lds;
#define PG8_G(T, x) ((T*)(__attribute__((address_space(1))) T*)(unsigned long long)(x))
        const float* rss_in = PG8_G(const float, P->rss_in); float* rss_out = PG8_G(float, P->rss_out); const float* base = PG8_G(const float, P->base); float* out = PG8_G(float, P->out);
        bf16_t* ob = PG8_G(bf16_t, P->ob); bf16_t* ob2 = PG8_G(bf16_t, P->ob2);
        const float* aux0 = PG8_G(const float, P->aux0); const float* aux1 = PG8_G(const float, P->aux1); const bf16_t* ua = PG8_G(const bf16_t, P->ua); float* fout = PG8_G(float, P->fout);
#undef PG8_G
#pragma unroll
        for (int ai = 0; ai < 2; ++ai)
#pragma unroll
            for (int m = 0; m < 4; ++m) {
                const int row = u.pm * BM + ai * HALF + wr * 64 + m * 16 + fr;
                float rs = 1.f;
                if (rs_lds) rs = ((const PG8_LAS float*)((const PG8_LAS char*)P + rs_lds))[row & 2047];
                else if (rss_in) {
                    float sq;
                    if (rss_n == 1) sq = gld4f(rss_in, rss_in + row);
                    else { const float* q = rss_in + (size_t)row * rss_n + fq * (rss_n >> 2);
                        if (rss_n == 4) sq = gld4f(rss_in, q);
                        else if (rss_n == 16) { const f32x4 v = gld16f(rss_in, q); sq = (v[0] + v[1]) + (v[2] + v[3]); }
                        else { const f32x4 v = gld16f(rss_in, q), w = gld16f(rss_in, q + 4); sq = ((v[0] + v[1]) + (v[2] + v[3])) + ((w[0] + w[1]) + (w[2] + w[3])); }
                        sq += __shfl_xor(sq, 16); sq += __shfl_xor(sq, 32); }
                    rs = __builtin_amdgcn_rsqf(sq * inv_k + 1e-6f);
                }
                const f32x4 a00 = acc[ai][0][m][0] * rs, a01 = acc[ai][0][m][1] * rs, a10 = acc[ai][1][m][0] * rs, a11 = acc[ai][1][m][1] * rs;
                const int cw = wc * 32 + 8 * fq;
                switch (mode) {
                case EM_SWIGLU: {
                    f32x4 v0, v1;
#pragma unroll
                    for (int i = 0; i < 4; ++i) { v0[i] = a00[i] * fast_sigmoid(a00[i]) * a10[i]; v1[i] = a01[i] * fast_sigmoid(a01[i]) * a11[i]; }
                    u32x4 w; w.x = cvt_pk_bf16(v0[0], v0[1]); w.y = cvt_pk_bf16(v0[2], v0[3]); w.z = cvt_pk_bf16(v1[0], v1[1]); w.w = cvt_pk_bf16(v1[2], v1[3]);
                    gst16(ob, ob + (size_t)row * ldo + u.pn * 128 + cw, w);
                } break;
                case EM_RES: {
                    float ss = 0.f;
#pragma unroll
                    for (int bj = 0; bj < 2; ++bj) {
                        const size_t off = (size_t)row * 1024 + u.pn * 256 + bj * 128 + cw;
                        const f32x4 b0 = gld16f(base, base + off), b1 = gld16f(base, base + off + 4);
                        const f32x4 v0 = b0 + alpha * (bj ? a10 : a00), v1 = b1 + alpha * (bj ? a11 : a01);
                        gst16f(out, out + off, v0); gst16f(out, out + off + 4, v1);
                        u32x4 w; w.x = cvt_pk_bf16(v0[0], v0[1]); w.y = cvt_pk_bf16(v0[2], v0[3]); w.z = cvt_pk_bf16(v1[0], v1[1]); w.w = cvt_pk_bf16(v1[2], v1[3]);
                        gst16(ob, ob + off, w);
                        ss += (v0[0] * v0[0] + v0[1] * v0[1]) + (v0[2] * v0[2] + v0[3] * v0[3]) + (v1[0] * v1[0] + v1[1] * v1[1]) + (v1[2] * v1[2] + v1[3] * v1[3]);
                    }
                    ss += __shfl_xor(ss, 16); ss += __shfl_xor(ss, 32);
                    if (fq == 0) gst4f(rss_out, rss_out + (size_t)row * 16 + u.pn * 4 + wc, ss);
                } break;
                case EM_GLU: {
                    const size_t off = (size_t)row * 1024 + u.pn * 128 + cw;
                    const f32x4 b0 = gld16f(base, base + off), b1 = gld16f(base, base + off + 4);
                    f32x4 v0, v1;
#pragma unroll
                    for (int i = 0; i < 4; ++i) { v0[i] = b0[i] + a00[i] * fast_sigmoid(a10[i]); v1[i] = b1[i] + a01[i] * fast_sigmoid(a11[i]); }
                    gst16f(out, out + off, v0); gst16f(out, out + off + 4, v1);
                    u32x4 w; w.x = cvt_pk_bf16(v0[0], v0[1]); w.y = cvt_pk_bf16(v0[2], v0[3]); w.z = cvt_pk_bf16(v1[0], v1[1]); w.w = cvt_pk_bf16(v1[2], v1[3]);
                    gst16(ob, ob + off, w);
                    float ss = (v0[0] * v0[0] + v0[1] * v0[1]) + (v0[2] * v0[2] + v0[3] * v0[3]) + (v1[0] * v1[0] + v1[1] * v1[1]) + (v1[2] * v1[2] + v1[3] * v1[3]);
                    ss += __shfl_xor(ss, 16); ss += __shfl_xor(ss, 32);
                    if (fq == 0) gst4f(rss_out, rss_out + (size_t)row * 32 + u.pn * 4 + wc, ss);
                } break;
                case EM_DKV: {
                    if (wc < 2) {
                        u32x4 w0, w1;
                        w0.x = cvt_pk_bf16(a00[0], a00[1]); w0.y = cvt_pk_bf16(a00[2], a00[3]); w0.z = cvt_pk_bf16(a01[0], a01[1]); w0.w = cvt_pk_bf16(a01[2], a01[3]);
                        w1.x = cvt_pk_bf16(a10[0], a10[1]); w1.y = cvt_pk_bf16(a10[2], a10[3]); w1.z = cvt_pk_bf16(a11[0], a11[1]); w1.w = cvt_pk_bf16(a11[2], a11[3]);
                        gst16(ob, ob + (size_t)row * P256 + cw, w0); gst16(ob, ob + (size_t)row * P256 + 64 + cw, w1);
                        float ss = 0.f;
#pragma unroll
                        for (int i = 0; i < 4; ++i) ss += a00[i] * a00[i] + a01[i] * a01[i] + a10[i] * a10[i] + a11[i] * a11[i];
                        ss += __shfl_xor(ss, 16); ss += __shfl_xor(ss, 32);
                        if (fq == 0) gst4f(rss_out, rss_out + (size_t)row * 4 + wc, ss);
                    } else if (wc == 2) {
                        if (fq == 0) { gst4f(rss_out, rss_out + (size_t)row * 4 + 2, 0.f); gst4f(rss_out, rss_out + (size_t)row * 4 + 3, 0.f); }
                        const int j0 = 8 * fq;
                        const f32x4 c0 = gld16f(aux0, aux0 + (size_t)row * 32 + j0), c1 = gld16f(aux0, aux0 + (size_t)row * 32 + j0 + 4);
                        const f32x4 s0 = gld16f(aux1, aux1 + (size_t)row * 32 + j0), s1 = gld16f(aux1, aux1 + (size_t)row * 32 + j0 + 4);
                        const f32x4 o10 = a00 * c0 - a10 * s0, o11 = a01 * c1 - a11 * s1, o20 = a00 * s0 + a10 * c0, o21 = a01 * s1 + a11 * c1;
                        u32x4 w0, w1;
                        w0.x = cvt_pk_bf16(o10[0], o10[1]); w0.y = cvt_pk_bf16(o10[2], o10[3]); w0.z = cvt_pk_bf16(o11[0], o11[1]); w0.w = cvt_pk_bf16(o11[2], o11[3]);
                        w1.x = cvt_pk_bf16(o20[0], o20[1]); w1.y = cvt_pk_bf16(o20[2], o20[3]); w1.z = cvt_pk_bf16(o21[0], o21[1]); w1.w = cvt_pk_bf16(o21[2], o21[3]);
                        gst16(ob2, ob2 + (size_t)row * 64 + j0, w0); gst16(ob2, ob2 + (size_t)row * 64 + 32 + j0, w1);
                    }
                } break;
                case EM_UKV: {
                    u32x4 w0, w1;
                    w0.x = cvt_pk_bf16(a00[0], a00[1]); w0.y = cvt_pk_bf16(a00[2], a00[3]); w0.z = cvt_pk_bf16(a01[0], a01[1]); w0.w = cvt_pk_bf16(a01[2], a01[3]);
                    w1.x = cvt_pk_bf16(a10[0], a10[1]); w1.y = cvt_pk_bf16(a10[2], a10[3]); w1.z = cvt_pk_bf16(a11[0], a11[1]); w1.w = cvt_pk_bf16(a11[2], a11[3]);
                    gst16(ob, ob + (size_t)row * 1024 + u.pn * 128 + cw, w0); gst16(ob2, ob2 + (size_t)row * 1024 + u.pn * 128 + cw, w1);
                } break;
                case EM_DQ: {
                    u32x4 w0, w1;
                    w0.x = cvt_pk_bf16(a00[0], a00[1]); w0.y = cvt_pk_bf16(a00[2], a00[3]); w0.z = cvt_pk_bf16(a01[0], a01[1]); w0.w = cvt_pk_bf16(a01[2], a01[3]);
                    w1.x = cvt_pk_bf16(a10[0], a10[1]); w1.y = cvt_pk_bf16(a10[2], a10[3]); w1.z = cvt_pk_bf16(a11[0], a11[1]); w1.w = cvt_pk_bf16(a11[2], a11[3]);
                    gst16(ob, ob + (size_t)row * P256 + cw, w0); gst16(ob, ob + (size_t)row * P256 + 128 + cw, w1);
                    float ss = 0.f;
#pragma unroll
                    for (int i = 0; i < 4; ++i) ss += a00[i] * a00[i] + a01[i] * a01[i] + a10[i] * a10[i] + a11[i] * a11[i];
                    ss += __shfl_xor(ss, 16); ss += __shfl_xor(ss, 32);
                    if (fq == 0) gst4f(rss_out, rss_out + (size_t)row * 4 + wc, ss);
                } break;
                case EM_UQ: {
                    const float qs = alpha;
                    if (u.pn < 4) {
                        u32x4 w0, w1;
                        w0.x = cvt_pk_bf16(a00[0] * qs, a00[1] * qs); w0.y = cvt_pk_bf16(a00[2] * qs, a00[3] * qs); w0.z = cvt_pk_bf16(a01[0] * qs, a01[1] * qs); w0.w = cvt_pk_bf16(a01[2] * qs, a01[3] * qs);
                        w1.x = cvt_pk_bf16(a10[0] * qs, a10[1] * qs); w1.y = cvt_pk_bf16(a10[2] * qs, a10[3] * qs); w1.z = cvt_pk_bf16(a11[0] * qs, a11[1] * qs); w1.w = cvt_pk_bf16(a11[2] * qs, a11[3] * qs);
                        gst16(ob, ob + (size_t)row * 1536 + (2 * u.pn) * 192 + cw, w0); gst16(ob, ob + (size_t)row * 1536 + (2 * u.pn + 1) * 192 + cw, w1);
                    } else {
                        const int head = 4 * (u.pn - 4) + wc, j0 = 8 * fq;
                        const f32x4 c0 = gld16f(aux0, aux0 + (size_t)row * 32 + j0) * qs, c1 = gld16f(aux0, aux0 + (size_t)row * 32 + j0 + 4) * qs;
                        const f32x4 s0 = gld16f(aux1, aux1 + (size_t)row * 32 + j0) * qs, s1 = gld16f(aux1, aux1 + (size_t)row * 32 + j0 + 4) * qs;
                        const f32x4 o10 = a00 * c0 - a10 * s0, o11 = a01 * c1 - a11 * s1, o20 = a00 * s0 + a10 * c0, o21 = a01 * s1 + a11 * c1;
                        u32x4 w0, w1;
                        w0.x = cvt_pk_bf16(o10[0], o10[1]); w0.y = cvt_pk_bf16(o10[2], o10[3]); w0.z = cvt_pk_bf16(o11[0], o11[1]); w0.w = cvt_pk_bf16(o11[2], o11[3]);
                        w1.x = cvt_pk_bf16(o20[0], o20[1]); w1.y = cvt_pk_bf16(o20[2], o20[3]); w1.z = cvt_pk_bf16(o21[0], o21[1]); w1.w = cvt_pk_bf16(o21[2], o21[3]);
                        bf16_t* qp = ob + (size_t)row * 1536 + head * 192 + 128 + j0;
                        gst16(ob, qp, w0); gst16(ob, qp + 32, w1);
                    }
                } break;
                case EM_SEND: {
                    float* p = fout + (size_t)row * 128 + cw;
                    gst16f(fout, p, a00); gst16f(fout, p + 4, a01);
                } break;
                case EM_Y: {
                    const int g = row >> 10, n = row & 1023;
#pragma unroll
                    for (int bj = 0; bj < 2; ++bj) {
                        const int c = bj * 128 + cw, tt = c >> 4, o0 = c & 15;
                        const u32x4 uu = gld16(ua, ua + (size_t)row * 384 + c);
                        const f32x4 d0 = *(const f32x4*)(aux0 + g * 16 + o0), d1 = *(const f32x4*)(aux0 + g * 16 + o0 + 4);
                        const f32x4 y0 = bj ? a10 : a00, y1 = bj ? a11 : a01;
                        float v[8];
                        { const h16x8 uh = __builtin_bit_cast(h16x8, uu);
                          v[0] = y0[0] + d0[0] * (float)uh[0]; v[1] = y0[1] + d0[1] * (float)uh[1]; v[2] = y0[2] + d0[2] * (float)uh[2]; v[3] = y0[3] + d0[3] * (float)uh[3];
                          v[4] = y1[0] + d1[0] * (float)uh[4]; v[5] = y1[1] + d1[1] * (float)uh[5]; v[6] = y1[2] + d1[2] * (float)uh[6]; v[7] = y1[3] + d1[3] * (float)uh[7]; }
#pragma unroll
                        for (int i = 0; i < 8; ++i) v[i] = gelu_tanh_f(v[i]);
                        u32x4 w; w.x = cvt_pk_bf16(v[0], v[1]); w.y = cvt_pk_bf16(v[2], v[3]); w.z = cvt_pk_bf16(v[4], v[5]); w.w = cvt_pk_bf16(v[6], v[7]);
                        gst16(ob, ob + (size_t)(16 * n + tt) * 1024 + g * 16 + o0, w);
                    }
                } break;
                default: break;
                }
            }
    }
};

template <class Epi, class Sched, bool ALIGN_EPI = false, bool SP2 = false>
__device__ __forceinline__ void gemm_phase(PG8_LAS unsigned char* lds, const Gemm g, const Sched& S, const Epi& E, int tid_in) {
    const int tid = tid_in, wid = __builtin_amdgcn_readfirstlane(tid >> 6), lane = tid & 63, wr = wid >> 2, wc = wid & 3, fr = lane & 15, fq = lane >> 4;
    const int K = g.K, nt = K / BK;
    unsigned voffA[2], voffB[2];
#pragma unroll
    for (int i = 0; i < 2; ++i) { int R, C; stage_rc(tid * 16 + i * 8192, R, C); const int Rb = Epi::PERM ? ((R & ~31) + perm32(R & 31)) : R;
        voffA[i] = (unsigned)(R * g.lda + C) * 2u; voffB[i] = (unsigned)(Rb * g.ldb + C) * 2u; }
    const size_t kstep = (size_t)(BK * 2);
    const size_t hstepA = (size_t)HALF * g.lda * 2, hstepB = (size_t)HALF * g.ldb * 2;
    const size_t tstepA = 2 * hstepA, tstepB = 2 * hstepB;
    const unsigned ldsw = (unsigned)wid * 1024u;
    const int aoff = lds_byte(wr * 64 + fr, fq * 8), boff = lds_byte(wc * 32 + fr, fq * 8);
#define PG8_SA(b, h) (((b) * 2 + (h)) * HTB)
#define PG8_SB(b, h) ((4 + (b) * 2 + (h)) * HTB)
#define PG8_STAGE(bufoff, gbase, voff) do { _Pragma("unroll") for (int _i = 0; _i < 2; ++_i) \
        __builtin_amdgcn_global_load_lds((const unsigned*)((const char*)(gbase) + (voff)[_i]), (PG8_LAS unsigned*)(lds + (bufoff) + ldsw + _i * 8192), 16, 0, PG8_AUX); } while (0)
#define PG8_LDA(dst, b, h) do { _Pragma("unroll") for (int m = 0; m < 4; ++m) _Pragma("unroll") for (int k = 0; k < 2; ++k) dst[m][k] = *(const PG8_LAS bf16x8*)(lds + PG8_SA(b, h) + aoff + m * 2048 + k * 1024); } while (0)
#define PG8_LDB(dst, b, h) do { _Pragma("unroll") for (int n = 0; n < 2; ++n) _Pragma("unroll") for (int k = 0; k < 2; ++k) dst[n][k] = *(const PG8_LAS bf16x8*)(lds + PG8_SB(b, h) + boff + n * 2048 + k * 1024); } while (0)
#define PG8_MMA(ai, bj, At, Bt) do { __builtin_amdgcn_s_setprio(1); _Pragma("unroll") for (int m = 0; m < 4; ++m) _Pragma("unroll") for (int n = 0; n < 2; ++n) _Pragma("unroll") for (int k = 0; k < 2; ++k) \
        acc[ai][bj][m][n] = __builtin_amdgcn_mfma_f32_16x16x32_f16(__builtin_bit_cast(h16x8, Bt[n][k]), __builtin_bit_cast(h16x8, At[m][k]), acc[ai][bj][m][n], 0, 0, 0); __builtin_amdgcn_s_setprio(0); } while (0)
#define PG8_WAIT_V(n) asm volatile("s_waitcnt vmcnt(" #n ")" ::: "memory")
#define PG8_WAIT_L(n) asm volatile("s_waitcnt lgkmcnt(" #n ")" ::: "memory")
#define PG8_BAR __builtin_amdgcn_s_barrier()
#define PG8_SCHED __builtin_amdgcn_sched_barrier(0)
    Unit cur, nxt; int ui = 0;
    if (!S.next(0, cur)) return;
    f32x4 acc[2][2][4][2];
#pragma unroll
    for (int a = 0; a < 2; ++a)
#pragma unroll
        for (int b = 0; b < 2; ++b)
#pragma unroll
            for (int m = 0; m < 4; ++m)
#pragma unroll
                for (int n = 0; n < 2; ++n) acc[a][b][m][n] = (f32x4){0.f, 0.f, 0.f, 0.f};
    bf16x8 At[4][2], B0[2][2], B1[2][2];
    const char* cA = (const char*)g.A + (size_t)cur.pm * tstepA; const char* cB = (const char*)g.Bt + (size_t)(cur.pm / g.bgt) * g.bgbytes + (size_t)cur.pn * tstepB;
    S.a_ready(cur);
    if constexpr (SP2) {
        PG8_STAGE(PG8_SB(0, 0), cB, voffB); PG8_STAGE(PG8_SB(0, 1), cB + hstepB, voffB); PG8_STAGE(PG8_SA(0, 0), cA, voffA); PG8_STAGE(PG8_SA(0, 1), cA + hstepA, voffA);
        if (wr == 1) PG8_BAR;
        PG8_WAIT_V(2); PG8_BAR;
        PG8_STAGE(PG8_SB(1, 0), cB + kstep, voffB); PG8_STAGE(PG8_SA(1, 0), cA + kstep, voffA); PG8_STAGE(PG8_SB(1, 1), cB + hstepB + kstep, voffB);
        PG8_WAIT_V(6); PG8_BAR;
    } else {
        PG8_STAGE(PG8_SB(0, 0), cB, voffB); PG8_STAGE(PG8_SA(0, 0), cA, voffA); PG8_STAGE(PG8_SB(0, 1), cB + hstepB, voffB); PG8_STAGE(PG8_SA(0, 1), cA + hstepA, voffA);
        if (wr == 1) PG8_BAR;
        PG8_WAIT_V(4); PG8_BAR;
        PG8_STAGE(PG8_SB(1, 0), cB + kstep, voffB); PG8_STAGE(PG8_SA(1, 0), cA + kstep, voffA); PG8_STAGE(PG8_SB(1, 1), cB + hstepB + kstep, voffB);
        PG8_WAIT_V(6); PG8_BAR;
    }
    for (;;) {
        const bool has_next = S.next(ui + 1, nxt);
        const char* nA = has_next ? (const char*)g.A + (size_t)nxt.pm * tstepA : cA; const char* nB = has_next ? (const char*)g.Bt + (size_t)(nxt.pm / g.bgt) * g.bgbytes + (size_t)nxt.pn * tstepB : cB;
        for (int t = 0; t < nt; t += 2) {
            const bool last = (t == nt - 2);
            const char* a1 = cA + (size_t)(t + 1) * kstep;
            const char* a2 = last ? nA : cA + (size_t)(t + 2) * kstep; const char* b2 = last ? nB : cB + (size_t)(t + 2) * kstep;
            const char* a3 = a2 + kstep; const char* b3 = b2 + kstep;
            if (last && has_next) S.a_ready(nxt);
            if constexpr (SP2) {
            PG8_LDB(B0, 0, 0); PG8_LDB(B1, 0, 1); PG8_SCHED; PG8_LDA(At, 0, 0); PG8_STAGE(PG8_SA(1, 1), a1 + hstepA, voffA);
            PG8_WAIT_V(8); PG8_WAIT_L(0); PG8_BAR; PG8_MMA(0, 0, At, B0); PG8_MMA(0, 1, At, B1); PG8_BAR; PG8_SCHED;
            PG8_LDA(At, 0, 1); PG8_STAGE(PG8_SB(0, 0), b2, voffB); PG8_STAGE(PG8_SB(0, 1), b2 + hstepB, voffB); PG8_STAGE(PG8_SA(0, 0), a2, voffA);
            PG8_WAIT_V(8); PG8_WAIT_L(0); PG8_BAR; PG8_MMA(1, 0, At, B0); PG8_MMA(1, 1, At, B1); PG8_BAR; PG8_SCHED;
            PG8_LDB(B0, 1, 0); PG8_LDB(B1, 1, 1); PG8_SCHED; PG8_LDA(At, 1, 0); PG8_STAGE(PG8_SA(0, 1), a2 + hstepA, voffA);
            PG8_WAIT_V(8); PG8_WAIT_L(0); PG8_BAR; PG8_MMA(0, 0, At, B0); PG8_MMA(0, 1, At, B1); PG8_BAR; PG8_SCHED;
            PG8_LDA(At, 1, 1); PG8_STAGE(PG8_SB(1, 0), b3, voffB); PG8_STAGE(PG8_SB(1, 1), b3 + hstepB, voffB); PG8_STAGE(PG8_SA(1, 0), a3, voffA);
            PG8_WAIT_V(8); PG8_WAIT_L(0); PG8_BAR; PG8_MMA(1, 0, At, B0); PG8_MMA(1, 1, At, B1); PG8_BAR; PG8_SCHED;
            } else {
            PG8_LDB(B0, 0, 0); PG8_SCHED; PG8_LDA(At, 0, 0); PG8_STAGE(PG8_SA(1, 1), a1 + hstepA, voffA);
            PG8_WAIT_L(8); PG8_BAR; PG8_WAIT_L(0); PG8_MMA(0, 0, At, B0); PG8_BAR; PG8_SCHED;
            PG8_LDB(B1, 0, 1); PG8_STAGE(PG8_SB(0, 0), b2, voffB);
            PG8_BAR; PG8_WAIT_L(0); PG8_MMA(0, 1, At, B1); PG8_BAR;
            PG8_LDA(At, 0, 1); PG8_STAGE(PG8_SA(0, 0), a2, voffA);
            PG8_BAR; PG8_WAIT_L(0); PG8_MMA(1, 0, At, B0); PG8_BAR; PG8_SCHED;
            PG8_STAGE(PG8_SB(0, 1), b2 + hstepB, voffB);
            PG8_WAIT_V(6); PG8_BAR; PG8_MMA(1, 1, At, B1); PG8_BAR;
            PG8_LDB(B0, 1, 0); PG8_SCHED; PG8_LDA(At, 1, 0); PG8_STAGE(PG8_SA(0, 1), a2 + hstepA, voffA);
            PG8_WAIT_L(8); PG8_BAR; PG8_WAIT_L(0); PG8_MMA(0, 0, At, B0); PG8_BAR; PG8_SCHED;
            PG8_LDB(B1, 1, 1); PG8_STAGE(PG8_SB(1, 0), b3, voffB);
            PG8_BAR; PG8_WAIT_L(0); PG8_MMA(0, 1, At, B1); PG8_BAR;
            PG8_LDA(At, 1, 1); PG8_STAGE(PG8_SA(1, 0), a3, voffA);
            PG8_BAR; PG8_WAIT_L(0); PG8_MMA(1, 0, At, B0); PG8_BAR; PG8_SCHED;
            PG8_STAGE(PG8_SB(1, 1), b3 + hstepB, voffB);
            PG8_WAIT_V(6); PG8_BAR; PG8_MMA(1, 1, At, B1); PG8_BAR;
            }
        }
        if constexpr (ALIGN_EPI) { if (wr == 0) PG8_BAR; }
        if constexpr (!Epi::AFTER_DRAIN) { E(acc, cur, wr, wc, fr, fq); S.done(cur); }
        if (!has_next) break;
#pragma unroll
        for (int a = 0; a < 2; ++a)
#pragma unroll
            for (int b = 0; b < 2; ++b)
#pragma unroll
                for (int m = 0; m < 4; ++m)
#pragma unroll
                    for (int n = 0; n < 2; ++n) acc[a][b][m][n] = (f32x4){0.f, 0.f, 0.f, 0.f};
        cur = nxt; cA = nA; cB = nB; ++ui;
        if constexpr (ALIGN_EPI) { if (wr == 1) PG8_BAR; }
    }
    PG8_WAIT_V(0);
    if constexpr (!ALIGN_EPI) { if (wr == 0) PG8_BAR; }
    PG8_BAR;
    if constexpr (Epi::AFTER_DRAIN) { E.fused(acc, cur, wr, wc, fr, fq, lds, wid, lane); S.done(cur); }
#undef PG8_SA
#undef PG8_SB
#undef PG8_STAGE
#undef PG8_LDA
#undef PG8_LDB
#undef PG8_MMA
#undef PG8_WAIT_V
#undef PG8_WAIT_L
#undef PG8_BAR
#undef PG8_SCHED
}

}

namespace attn {
typedef unsigned short bf16_t;
using bf16x8 = __attribute__((ext_vector_type(8))) short;
using s16x4 = __attribute__((ext_vector_type(4))) short;
using f32x16 = __attribute__((ext_vector_type(16))) float;
using u32x4 = __attribute__((ext_vector_type(4))) unsigned;
constexpr int NW = 8, QBLK = 32, KVBLK = 64;
constexpr int SHM_V = KVBLK * 128 * 2, SHM_K = KVBLK * 192 * 2, SHM_ATTN = 2 * SHM_V + 2 * SHM_K + NW * 64 * 4;
constexpr float THR = 8.f;
#ifndef ATTN_SDEPTH
#define ATTN_SDEPTH 2
#endif
constexpr int SDEPTH = ATTN_SDEPTH;
#define KSWZ(row, colB) ((row) * 384 + ((colB) ^ ((((row) >> 1) & 7) << 4)))
#define SBAR() __builtin_amdgcn_sched_barrier(0)
__device__ __forceinline__ int crow(int r, int hi) { return (r & 3) + 8 * (r >> 2) + 4 * hi; }
__device__ __forceinline__ unsigned cvtpk(float lo, float hi) { return pk2(lo, hi); }

__device__ __forceinline__ void partialSM(f32x16& p0, f32x16& p1, float& m_reg, float& mn, float& alpha) {
  float pmax = p0[0];
#pragma unroll
  for (int r = 1; r < 16; ++r) pmax = fmaxf(pmax, p0[r]);
#pragma unroll
  for (int r = 0; r < 16; ++r) pmax = fmaxf(pmax, p1[r]);
  { auto rr = __builtin_amdgcn_permlane32_swap(__float_as_uint(pmax), __float_as_uint(pmax), false, false);
    pmax = fmaxf(__uint_as_float(rr[0]), __uint_as_float(rr[1])); }
  if (__builtin_expect(__all(pmax - m_reg <= THR), 1)) { mn = m_reg; alpha = 1.f; }
  else { mn = fmaxf(m_reg, pmax); alpha = __builtin_amdgcn_exp2f(m_reg - mn); m_reg = mn; }
#pragma unroll
  for (int r = 0; r < 16; ++r) p0[r] = p0[r] - mn;
#pragma unroll
  for (int r = 0; r < 16; ++r) p1[r] = p1[r] - mn;
#pragma unroll
  for (int r = 0; r < 16; ++r) p0[r] = __builtin_amdgcn_exp2f(p0[r]);
}
__device__ __forceinline__ void finishSM(f32x16& p0, f32x16& p1, float alpha, float& l_reg, bf16x8& pa0, bf16x8& pa1, bf16x8& pa2, bf16x8& pa3) {
#pragma unroll
  for (int r = 0; r < 16; ++r) p1[r] = __builtin_amdgcn_exp2f(p1[r]);
  float ps = 0;
#pragma unroll
  for (int r = 0; r < 16; ++r) ps += p0[r];
#pragma unroll
  for (int r = 0; r < 16; ++r) ps += p1[r];
  { auto rr = __builtin_amdgcn_permlane32_swap(__float_as_uint(ps), __float_as_uint(ps), false, false);
    ps = __uint_as_float(rr[0]) + __uint_as_float(rr[1]); }
  l_reg = l_reg * alpha + ps;
#define PK4(P, BASE, OUT) do { unsigned a0 = cvtpk(P[BASE + 0], P[BASE + 1]), a1 = cvtpk(P[BASE + 2], P[BASE + 3]);   \
    unsigned b0 = cvtpk(P[BASE + 4], P[BASE + 5]), b1 = cvtpk(P[BASE + 6], P[BASE + 7]);                              \
    auto r0 = __builtin_amdgcn_permlane32_swap(a0, b0, false, false); auto r1 = __builtin_amdgcn_permlane32_swap(a1, b1, false, false); \
    u32x4 w = {r0[0], r1[0], r0[1], r1[1]}; OUT = *reinterpret_cast<bf16x8*>(&w); } while (0)
  PK4(p0, 0, pa0); PK4(p0, 8, pa1); PK4(p1, 0, pa2); PK4(p1, 8, pa3);
#undef PK4
}
__device__ __forceinline__ void qkt(f32x16& p0, f32x16& p1, const char* Ks, const bf16x8* qr, int r32, int hi) {
  p0 = f32x16{}; p1 = f32x16{};
  __builtin_amdgcn_s_setprio(1);
#pragma unroll
  for (int d0 = 0; d0 < 12; ++d0) { const int cb = (d0 * 16 + hi * 8) * 2;
    const bf16x8 b0 = *reinterpret_cast<const bf16x8*>(Ks + KSWZ(r32, cb));
    const bf16x8 b1 = *reinterpret_cast<const bf16x8*>(Ks + KSWZ(32 + r32, cb));
    p0 = __builtin_amdgcn_mfma_f32_32x32x16_f16(__builtin_bit_cast(h16x8, b0), __builtin_bit_cast(h16x8, qr[d0]), p0, 0, 0, 0);
    p1 = __builtin_amdgcn_mfma_f32_32x32x16_f16(__builtin_bit_cast(h16x8, b1), __builtin_bit_cast(h16x8, qr[d0]), p1, 0, 0, 0); }
  __builtin_amdgcn_s_setprio(0);
}
__device__ __forceinline__ int v_st(int k, int c) { const int kk = (k & ~0xC) | ((k & 4) << 1) | ((k & 8) >> 1); return ((kk >> 3) * 4 + (c >> 5)) * 512 + ((kk & 7) * 32 + (c & 31)) * 2; }
__device__ __forceinline__ int v_rd_base(int lane) { return ((lane & 3) << 3) | (((lane >> 2) & 3) << 6) | (((lane >> 4) & 1) << 5) | (((lane >> 5) & 1) << 8); }
constexpr int v_rd_off(int d0, int ks, int half) { return d0 * 512 + ks * 4096 + half * 2048; }
template <int OFF> __device__ __forceinline__ s16x4 tr_read(int vb) {
  s16x4 r; asm volatile("ds_read_b64_tr_b16 %0, %1 offset:%2" : "=&v"(r) : "v"(vb), "i"(OFF) : "memory"); return r;
}
template <int D0> __device__ __forceinline__ void pv_one(f32x16& od, int vb, bf16x8 pa0, bf16x8 pa1, bf16x8 pa2, bf16x8 pa3) {
  const s16x4 l0 = tr_read<v_rd_off(D0, 0, 0)>(vb), h0 = tr_read<v_rd_off(D0, 0, 1)>(vb), l1 = tr_read<v_rd_off(D0, 1, 0)>(vb), h1 = tr_read<v_rd_off(D0, 1, 1)>(vb);
  const s16x4 l2 = tr_read<v_rd_off(D0, 2, 0)>(vb), h2 = tr_read<v_rd_off(D0, 2, 1)>(vb), l3 = tr_read<v_rd_off(D0, 3, 0)>(vb), h3 = tr_read<v_rd_off(D0, 3, 1)>(vb);
  asm volatile("s_waitcnt lgkmcnt(0)" ::: "memory"); SBAR();
  __builtin_amdgcn_s_setprio(1);
#define PK(L, H) (bf16x8){L[0], L[1], L[2], L[3], H[0], H[1], H[2], H[3]}
  od = __builtin_amdgcn_mfma_f32_32x32x16_f16(__builtin_bit_cast(h16x8, pa0), __builtin_bit_cast(h16x8, PK(l0, h0)), od, 0, 0, 0);
  od = __builtin_amdgcn_mfma_f32_32x32x16_f16(__builtin_bit_cast(h16x8, pa1), __builtin_bit_cast(h16x8, PK(l1, h1)), od, 0, 0, 0);
  od = __builtin_amdgcn_mfma_f32_32x32x16_f16(__builtin_bit_cast(h16x8, pa2), __builtin_bit_cast(h16x8, PK(l2, h2)), od, 0, 0, 0);
  od = __builtin_amdgcn_mfma_f32_32x32x16_f16(__builtin_bit_cast(h16x8, pa3), __builtin_bit_cast(h16x8, PK(l3, h3)), od, 0, 0, 0);
  __builtin_amdgcn_s_setprio(0);
#undef PK
}
__device__ __forceinline__ void pv_d0(f32x16* o, int vb, bf16x8 pa0, bf16x8 pa1, bf16x8 pa2, bf16x8 pa3) {
  pv_one<0>(o[0], vb, pa0, pa1, pa2, pa3); pv_one<1>(o[1], vb, pa0, pa1, pa2, pa3); pv_one<2>(o[2], vb, pa0, pa1, pa2, pa3); pv_one<3>(o[3], vb, pa0, pa1, pa2, pa3);
}

__device__ __forceinline__ void attn_unit(const bf16_t* __restrict__ Qu, const bf16_t* __restrict__ Knh, const bf16_t* __restrict__ Krb, const bf16_t* __restrict__ Vh,
                                          bf16_t* __restrict__ Ou, int NT, int qb4, char* lds, int tid_in) {
  const int tid = tid_in, wid = __builtin_amdgcn_readfirstlane(tid >> 6), lane = tid & 63, r32 = lane & 31, hi = lane >> 5;
  const int lim = qb4 + (wid >> 1);
  char* V_lds = lds; char* K_lds = lds + 2 * SHM_V;
  float* ws = (float*)(lds + 2 * SHM_V + 2 * SHM_K) + wid * 64; float* li_l = ws; float* al_l = ws + 32;
  float m_reg = -1e30f, l_reg = 0; f32x16 o[4] = {}; bf16x8 qr[12];
  const bf16_t* Qw = Qu + (long)(wid * QBLK + r32) * 1536 + hi * 8;
#pragma unroll
  for (int d0 = 0; d0 < 12; ++d0) qr[d0] = __builtin_bit_cast(bf16x8, gld16(Qu, Qw + d0 * 16));
  const int kr0 = tid >> 4, kch = tid & 15, rr0 = tid >> 3, rch = tid & 7, vsc = (tid & 15) * 8;
  const int kst0 = KSWZ(kr0, kch * 16), kst1 = KSWZ(32 + kr0, kch * 16), kst2 = KSWZ(rr0, 256 + rch * 16), vst0 = v_st(kr0, vsc), vst1 = v_st(32 + kr0, vsc);
  const int vb0 = (int)(uintptr_t)V_lds + v_rd_base(lane);
  bf16x8 sk0, sk1, sk2, sv0, sv1;
#define LD8B(base, p) (__builtin_bit_cast(bf16x8, gld16((base), (p))))
#define SLOAD(key0) do { sv0 = LD8B(Vh, Vh + (long)((key0) + kr0) * 1024 + vsc); sv1 = LD8B(Vh, Vh + (long)((key0) + 32 + kr0) * 1024 + vsc); \
    sk0 = LD8B(Knh, Knh + (long)((key0) + kr0) * 1024 + kch * 8); sk1 = LD8B(Knh, Knh + (long)((key0) + 32 + kr0) * 1024 + kch * 8); \
    sk2 = LD8B(Krb, Krb + (long)((key0) + rr0) * 64 + rch * 8); } while (0)
#define SWRITE(b) do { *(bf16x8*)(V_lds + (b) * SHM_V + vst0) = sv0; *(bf16x8*)(V_lds + (b) * SHM_V + vst1) = sv1; \
    *(bf16x8*)(K_lds + (b) * SHM_K + kst0) = sk0; *(bf16x8*)(K_lds + (b) * SHM_K + kst1) = sk1; *(bf16x8*)(K_lds + (b) * SHM_K + kst2) = sk2; } while (0)
  SLOAD(0); asm volatile("s_waitcnt vmcnt(0)" ::: "memory"); SWRITE(0); __syncthreads();
  for (int j = 0; j < NT; ++j) {
    const int buf = j & 1;
    if (j + 1 < NT) SLOAD((j + 1) * KVBLK);
    if (j <= lim) {
      f32x16 p0, p1; float mn, alpha; bf16x8 pa0, pa1, pa2, pa3;
      qkt(p0, p1, K_lds + buf * SHM_K, qr, r32, hi);
      partialSM(p0, p1, m_reg, mn, alpha);
      finishSM(p0, p1, alpha, l_reg, pa0, pa1, pa2, pa3);
      if (__any(alpha < 1.f)) { if (hi == 0) al_l[r32] = alpha; asm volatile("s_waitcnt lgkmcnt(0)" ::: "memory");
#pragma unroll
        for (int d = 0; d < 4; ++d)
#pragma unroll
          for (int r = 0; r < 16; ++r) o[d][r] *= al_l[crow(r, hi)]; }
      SBAR();
      pv_d0(o, vb0 + buf * (int)SHM_V, pa0, pa1, pa2, pa3);
    }
    if (j + 1 < NT) { asm volatile("s_waitcnt vmcnt(0)" ::: "memory"); SWRITE(buf ^ 1); }
    __syncthreads();
  }
  if (hi == 0) li_l[r32] = l_reg; asm volatile("s_waitcnt lgkmcnt(0)" ::: "memory");
  float rli[16];
#pragma unroll
  for (int r = 0; r < 16; ++r) rli[r] = __builtin_amdgcn_rcpf(li_l[crow(r, hi)]);
  bf16_t* Ow = Ou + (long)(wid * QBLK) * 1024;
#pragma unroll
  for (int r = 0; r < 16; ++r) { const int orow = crow(r, hi);
#pragma unroll
    for (int d0 = 0; d0 < 4; ++d0) gst2(Ou, Ow + (long)orow * 1024 + d0 * 32 + r32, (bf16_t)(cvtpk(o[d0][r] * rli[r], 0.f) & 0xffffu)); }
  __syncthreads();
#undef LD8B
#undef SLOAD
#undef SWRITE
}
__device__ __forceinline__ void attn_phase(char* lds, const bf16_t* Q, const bf16_t* Kn, const bf16_t* Kr, const bf16_t* V, bf16_t* O, int vcu, int G, int tid_in) {
  for (int v = vcu; v < 256; v += G) {
    const int bh = v >> 2, b = bh >> 3, h = bh & 7, s = v & 3;
#pragma unroll 1
    for (int i = 0; i < 2; ++i) {
      const int qb = i ? 7 - s : s;
      const long row0 = (long)b * 2048 + qb * 256;
      attn_unit(Q + row0 * 1536 + h * 192, Kn + (long)b * 2048 * 1024 + h * 128, Kr + (long)b * 2048 * 64, V + (long)b * 2048 * 1024 + h * 128, O + row0 * 1024 + h * 128, 4 * qb + 4, 4 * qb, lds, tid_in);
    }
  }
}
#undef KSWZ
#undef SBAR
}


#define XB_TMO      128
#define XB_XCNT(j)  (256  + 64 * (j))
#define XB_XSUB(j)  (1280 + 64 * (j))
#define XB_XGEN(j)  (2304 + 64 * (j))
#define XB_TOP      3328
#define XB_TOPGEN   3392
#define XCD_BAR_WORDS 3456
#define XB_SPIN_CAP (1u << 18)

__device__ __forceinline__ unsigned xb_ld(unsigned* p)              { return __hip_atomic_load(p, __ATOMIC_RELAXED, __HIP_MEMORY_SCOPE_AGENT); }
__device__ __forceinline__ unsigned xb_add(unsigned* p, unsigned v) { return __hip_atomic_fetch_add(p, v, __ATOMIC_RELAXED, __HIP_MEMORY_SCOPE_AGENT); }
__device__ __forceinline__ unsigned xb_xcc_id() { return (unsigned)__builtin_amdgcn_s_getreg((3 << 11) | 20) & 0xFu; }
#define XB_SPIN(cond, bar) do { unsigned _sp = 0; while (cond) { __builtin_amdgcn_s_sleep(1); \
    if ((++_sp & 255u) == 0u) { if (xb_ld(&(bar)[XB_TMO])) break; if (_sp > XB_SPIN_CAP) { atomicAdd(&(bar)[XB_TMO], 1u); break; } } } } while (0)

struct XcdBarrier {
    unsigned* bar; unsigned x;
    volatile LAS unsigned* st;
};

__device__ __forceinline__ XcdBarrier xcd_barrier_post(unsigned* bar, volatile LAS unsigned* st) {
    XcdBarrier b; b.bar = bar; b.x = xb_xcc_id(); b.st = st;
    if (threadIdx.x == 0) (void)xb_add(&bar[XB_XCNT(b.x)], 1u);
    return b;
}
__device__ __forceinline__ void xcd_barrier_complete(unsigned* bar, unsigned x, unsigned& nloc, unsigned& nx) {
    const unsigned G = gridDim.x * gridDim.y * gridDim.z;
    unsigned sum, cnt, mine, sp = 0u;
    for (;;) {
        sum = 0u; cnt = 0u; mine = 0u;
#pragma unroll
        for (unsigned j = 0; j < 16; ++j) { const unsigned c = xb_ld(&bar[XB_XCNT(j)]); sum += c; cnt += (c > 0u) ? 1u : 0u; mine = (j == x) ? c : mine; }
        if (sum == G) break;
        __builtin_amdgcn_s_sleep(1);
        if ((++sp & 255u) == 0u) { if (xb_ld(&bar[XB_TMO])) break; if (sp > XB_SPIN_CAP) { atomicAdd(&bar[XB_TMO], 1u); break; } }
    }
    nloc = mine > 0u ? mine : 1u; nx = cnt > 0u ? cnt : 1u;
}

__device__ __forceinline__ void xcd_barrier(const XcdBarrier& b) {
    asm volatile("s_waitcnt vmcnt(0)" ::: "memory");
    __syncthreads();
    if (threadIdx.x == 0) {
        unsigned* bar = b.bar;
        __builtin_amdgcn_s_waitcnt(0);
        unsigned nloc = b.st[0], nx = b.st[1];
        if (nloc == 0u) { xcd_barrier_complete(bar, b.x, nloc, nx); b.st[0] = nloc; b.st[1] = nx; }
        const unsigned old = xb_add(&bar[XB_XSUB(b.x)], 1u);
        const unsigned gen = old / nloc;
        if (old + 1u == (gen + 1u) * nloc) {
            __builtin_amdgcn_fence(__ATOMIC_RELEASE, "agent");
            asm volatile("s_waitcnt vmcnt(0)" ::: "memory");
            const unsigned og = xb_add(&bar[XB_TOP], 1u);
            const unsigned tg = og / nx;
            if (og + 1u == (tg + 1u) * nx) xb_add(&bar[XB_TOPGEN], 1u);
            else XB_SPIN(xb_ld(&bar[XB_TOPGEN]) == tg, bar);
            __builtin_amdgcn_fence(__ATOMIC_ACQUIRE, "agent");
            xb_add(&bar[XB_XGEN(b.x)], 1u);
            asm volatile("s_waitcnt vmcnt(0)" ::: "memory");
        } else {
            XB_SPIN(xb_ld(&bar[XB_XGEN(b.x)]) == gen, bar);
            __builtin_amdgcn_fence(__ATOMIC_ACQUIRE, "agent");
            asm volatile("s_waitcnt vmcnt(0)" ::: "memory");
        }
    }
    __syncthreads();
}


__device__ __forceinline__ void sb_begin(unsigned* ctlw) {
    if (threadIdx.x == 0) {
        unsigned e1 = 0xAAAAAAAAu, e2 = 0xAAAAAAAAu;
        __hip_atomic_compare_exchange_strong(ctlw + CW_BAR + 64, &e1, 0u, __ATOMIC_RELAXED, __ATOMIC_RELAXED, __HIP_MEMORY_SCOPE_AGENT);
        __hip_atomic_compare_exchange_strong(ctlw + CW_BAR + 128, &e2, 0u, __ATOMIC_RELAXED, __ATOMIC_RELAXED, __HIP_MEMORY_SCOPE_AGENT);
    }
}
__device__ __forceinline__ void sb_end(unsigned* ctlw) {
    if (threadIdx.x == 0) {
        const unsigned G = gridDim.x * gridDim.y * gridDim.z;
        if (__hip_atomic_fetch_add(ctlw + CW_BAR + 128, 1u, __ATOMIC_RELAXED, __HIP_MEMORY_SCOPE_AGENT) == G - 1u) {
            __hip_atomic_store(ctlw + CW_BAR + 64, 0u, __ATOMIC_RELAXED, __HIP_MEMORY_SCOPE_AGENT);
            __hip_atomic_store(ctlw + CW_BAR + 128, 0u, __ATOMIC_RELAXED, __HIP_MEMORY_SCOPE_AGENT);
        }
    }
}
__device__ __forceinline__ void simple_barrier(unsigned* ctlw, volatile LAS unsigned* misc) {
    unsigned* cnt = ctlw + CW_BAR + 64;
    asm volatile("s_waitcnt vmcnt(0)" ::: "memory");
#ifdef MK_DIAG
    { const int w = __builtin_amdgcn_readfirstlane(threadIdx.x >> 6);
      if ((threadIdx.x & 63) == 0) misc[16 + w] = misc[16 + w] + 1u; }
#endif
    __syncthreads();
    if (threadIdx.x == 0) {
        const unsigned e = misc[10] + 1u; misc[10] = e;
#ifdef MK_DIAG
        { unsigned bad = 0; for (int w = 0; w < 8; ++w) bad |= (misc[16 + w] != e); if (bad) atomicMax(ctlw + CW_CODE, 3u); }
        __hip_atomic_store(ctlw + 8192 + 64 * blockIdx.x, e, __ATOMIC_RELAXED, __HIP_MEMORY_SCOPE_WORKGROUP);
        asm volatile("s_waitcnt vmcnt(0)" ::: "memory");
#endif
#ifdef MK_SYS_FENCE
        __builtin_amdgcn_fence(__ATOMIC_RELEASE, "");
#else
        __builtin_amdgcn_fence(__ATOMIC_RELEASE, "agent");
#endif
        asm volatile("s_waitcnt vmcnt(0)" ::: "memory");
#ifdef DG_DELAY
        { const unsigned long long td = __builtin_amdgcn_s_memrealtime(); while (__builtin_amdgcn_s_memrealtime() - td < 5000ull) __builtin_amdgcn_s_sleep(8); }
#endif
        const unsigned want = e * (gridDim.x * gridDim.y * gridDim.z);
        __hip_atomic_fetch_add(cnt, 1u, __ATOMIC_RELAXED, __HIP_MEMORY_SCOPE_AGENT);
        const unsigned long long t0 = __builtin_amdgcn_s_memrealtime();
        while (__hip_atomic_load(cnt, __ATOMIC_RELAXED, __HIP_MEMORY_SCOPE_AGENT) < want) {
            __builtin_amdgcn_s_sleep(2);
            if (__builtin_amdgcn_s_memrealtime() - t0 > 5000000ull) { atomicMax(ctlw + CW_CODE, 1u); break; }
        }
#ifdef MK_SYS_FENCE
        __builtin_amdgcn_fence(__ATOMIC_ACQUIRE, "");
#else
        __builtin_amdgcn_fence(__ATOMIC_ACQUIRE, "agent");
#endif
        asm volatile("s_waitcnt vmcnt(0)" ::: "memory");
    }
    __syncthreads();
#ifdef MK_DIAG
    { const unsigned e = misc[10];
      const unsigned other = (blockIdx.x * 37u + threadIdx.x) % (gridDim.x);
      const unsigned v = *(const volatile unsigned*)(ctlw + 8192 + 64 * other);
      if (v != e) atomicMax(ctlw + CW_CODE, 2u); }
#endif
}
#ifdef MK_SIMPLE_BAR
#define GRID_BARRIER() simple_barrier((unsigned*)F.ctl, F.MISC)
#else
#define GRID_BARRIER() xcd_barrier(bar)
#endif

struct Args { const float* in[23]; float* out; unsigned char* ws; int ph_lo, ph_hi, li, pad; };
struct Frame {
    LAS unsigned char* lds;
    volatile LAS unsigned* MISC;
    gu32* ctl;
    int tid, lane, wave, vcu, G;
};

struct GemmParams { const bf16* A; const bf16* Bt; size_t bgbytes; int lda, ldb, K, bgt, gM, gN, crot, is_gemm, gsz, cskip; };
static_assert(sizeof(pg8::EpiParams) <= 128 && sizeof(GemmParams) <= 72 && PT_OFF + 24 * 8 <= LDS_BYTES, "LDS parameter blocks");
__device__ __forceinline__ unsigned long long rfl64(unsigned long long v) {
    const unsigned lo = __builtin_amdgcn_readfirstlane((unsigned)v), hi = __builtin_amdgcn_readfirstlane((unsigned)(v >> 32)); return ((unsigned long long)hi << 32) | lo; }
__device__ __forceinline__ void conv_item(const float* W, int ldw, int Ksrc, int srccol, const float* gain, bf16* WT, int ldk, int dstrow0, int k0, LAS float* scr, int lane) {
    const bool zero = (srccol < 0) || (k0 >= Ksrc);
    const int r8 = lane >> 3, c4 = (lane & 7) * 4;
    f32x4 v[8];
    if (!zero) {
#pragma unroll
        for (int i = 0; i < 8; ++i) v[i] = *(const GAS f32x4*)(unsigned long long)(W + (size_t)(k0 + 8 * i + r8) * ldw + srccol + c4);
        if (gain) {
#pragma unroll
            for (int i = 0; i < 8; ++i) v[i] = v[i] * gain[k0 + 8 * i + r8];
        }
    } else {
#pragma unroll
        for (int i = 0; i < 8; ++i) v[i] = (f32x4){0.f, 0.f, 0.f, 0.f};
    }
#pragma unroll
    for (int i = 0; i < 8; ++i) { LAS float* d = scr + (8 * i + r8) * 33 + c4; d[0] = v[i][0]; d[1] = v[i][1]; d[2] = v[i][2]; d[3] = v[i][3]; }
    LDS_WAIT(); asm volatile("" ::: "memory");
    const int c = lane & 7;
#pragma unroll
    for (int j = 0; j < 4; ++j) { const int n = (lane >> 3) + 8 * j; const LAS float* sp = scr + (8 * c) * 33 + n;
        v4u o; o.x = pk2(sp[0 * 33], sp[1 * 33]); o.y = pk2(sp[2 * 33], sp[3 * 33]); o.z = pk2(sp[4 * 33], sp[5 * 33]); o.w = pk2(sp[6 * 33], sp[7 * 33]);
        gst16(WT, WT + (size_t)(dstrow0 + n) * ldk + k0 + 8 * c, o); }
    LDS_WAIT(); asm volatile("" ::: "memory");
}
__device__ __forceinline__ int map_pair(int n0, int half_off) { const int pn = n0 >> 8, t = n0 & 255; return (t >> 7) * half_off + 128 * pn + (t & 127); }
__device__ __forceinline__ int map_dkv(int t) { if (t < 64) return t; if (t < 96) return 128 + (t - 64); if (t < 128) return -1; if (t < 192) return 64 + (t - 128); if (t < 224) return 160 + (t - 192); return -1; }
__device__ __forceinline__ int map_uq(int n0) {
    if (n0 < 1024) { const int pn = n0 >> 8, t = n0 & 255; return (2 * pn + (t >> 7)) * 192 + (t & 127); }
    const int r = n0 - 1024, q = r >> 8, t = r & 255, bj = t >> 7, hh = (t & 127) >> 5; return (4 * q + hh) * 192 + 128 + 32 * bj + (t & 31);
}
struct ConvJob { const float* W; int ldw, Ksrc, Kdst, Ndst, map; const float* gain; bf16* WT; int ldk; };
__device__ __forceinline__ void conv_job_item(const ConvJob& j, int item, LAS float* scr, int lane) {
    const int nblk = j.Ndst / 32, kb = item / nblk, nb = item % nblk, k0 = 64 * kb, n0 = 32 * nb;
    int sc;
    switch (j.map) { case 1: sc = map_pair(n0, FF); break; case 2: sc = map_pair(n0, 1024); break; case 3: sc = map_dkv(n0); break; case 4: sc = map_uq(n0); break; default: sc = n0; }
    conv_item(j.W, j.ldw, j.Ksrc, sc, j.gain, j.WT, j.ldk, n0, k0, scr, lane);
}

__device__ __forceinline__ void xconv_rows(Frame& F, const float* x, bf16* xb, float* rss) {
    const int gw = F.vcu * NWAVES + F.wave, NGW = F.G * NWAVES;
    for (int m = gw; m < M; m += NGW) {
        const GAS f32x4* xr = (const GAS f32x4*)(x + (size_t)m * D) + F.lane;
        f32x4 v[4]; float s = 0.f;
#pragma unroll
        for (int j = 0; j < 4; ++j) { v[j] = xr[64 * j]; s += (v[j].x * v[j].x + v[j].y * v[j].y) + (v[j].z * v[j].z + v[j].w * v[j].w); }
        s = wave_sum(s);
        if (F.lane == 0) gst4f(rss, rss + m, s);
        v2u* o8 = (v2u*)(xb + (size_t)m * D) + F.lane;
#pragma unroll
        for (int j = 0; j < 4; ++j) { v2u w; w.x = pk2(v[j].x, v[j].y); w.y = pk2(v[j].z, v[j].w);
            gst8(xb, o8 + 64 * j, w);
        }
    }
}
__device__ __forceinline__ void rss_rows(Frame& F, const float* x, float* rss) {
    const int gw = F.vcu * NWAVES + F.wave, NGW = F.G * NWAVES;
    for (int m = gw; m < M; m += NGW) {
        const GAS f32x4* xr = (const GAS f32x4*)(x + (size_t)m * D) + F.lane;
        float s = 0.f;
#pragma unroll
        for (int j = 0; j < 4; ++j) { const f32x4 v = xr[64 * j]; s += (v.x * v.x + v.y * v.y) + (v.z * v.z + v.w * v.w); }
        s = wave_sum(s);
        if (F.lane == 0) rss[m] = s;
    }
}
__device__ __forceinline__ void uconv_rows(Frame& F, const float* x, const float* rss, int nslot, const float* gain, bf16* ug) {
    const int gw = F.vcu * NWAVES + F.wave, NGW = F.G * NWAVES;
    f32x4 gv[4];
#pragma unroll
    for (int j = 0; j < 4; ++j) gv[j] = *(const f32x4*)(gain + F.lane * 16 + 4 * j);
    for (int m = gw; m < M; m += NGW) {
        const float r = __builtin_amdgcn_rsqf(wave_sum(F.lane < nslot ? gld4f(rss, rss + (size_t)m * nslot + F.lane) : 0.f) * (1.f / 1024.f) + EPS);
        const f32x4* xr = (const f32x4*)(x + (size_t)m * D + F.lane * 16);
        f32x4 v[4];
#pragma unroll
        for (int j = 0; j < 4; ++j) v[j] = gld16f(x, xr + j) * gv[j] * r;
        v4u w0, w1;
        w0.x = pk2(v[0].x, v[0].y); w0.y = pk2(v[0].z, v[0].w); w0.z = pk2(v[1].x, v[1].y); w0.w = pk2(v[1].z, v[1].w);
        w1.x = pk2(v[2].x, v[2].y); w1.y = pk2(v[2].z, v[2].w); w1.z = pk2(v[3].x, v[3].y); w1.w = pk2(v[3].z, v[3].w);
        bf16* dst = ug + ((size_t)F.lane * 1024 + (m >> 4)) * 384 + (m & 15) * 16;
        gst16(ug, dst, w0); gst16(ug, dst + 8, w1);
    }
}
__device__ __forceinline__ void s5_tables(Frame& F, int g, const float* lam_re, const float* lam_im, const float* log_step, const float* b_re, const float* b_im,
                                          const float* c_re, const float* c_im, bf16* TH, bf16* GT, float* L16) {
    LAS float* L = (LAS float*)(F.lds + RING_OFF);
    LAS float* pwr = L;
    LAS float* pwi = L + 17 * 64;
    LAS float* bbr = L + 34 * 64;
    LAS float* bbi = bbr + 1024;
    LAS float* ccr = bbi + 1024;
    LAS float* cci = ccr + 1024;
    LAS float* Kt = cci + 1024;
    const int tid = F.tid;
    if (tid < 64) {
        const int p = tid;
        const float step = expf(log_step[g]);
        const float lr = lam_re[g * 64 + p], li = lam_im[g * 64 + p];
        const double ang1 = (double)li * (double)step;
        for (int tau = 0; tau <= 16; ++tau) {
            double a = ang1 * (double)tau; a -= 6.283185307179586476925 * __builtin_rint(a * 0.15915494309189533577);
            const float mag = expf(lr * step * (float)tau), af = (float)a;
            pwr[tau * 64 + p] = mag * cosf(af); pwi[tau * 64 + p] = mag * sinf(af);
        }
        const float lbr = pwr[64 + p], lbi = pwi[64 + p];
        const float nr = lbr - 1.f, ni = lbi, den = lr * lr + li * li;
        const float cr = (nr * lr + ni * li) / den, ci = (ni * lr - nr * li) / den;
        for (int i = 0; i < 16; ++i) { const float br = b_re[((size_t)g * 64 + p) * 16 + i], bi = b_im[((size_t)g * 64 + p) * 16 + i];
            bbr[p * 16 + i] = cr * br - ci * bi; bbi[p * 16 + i] = cr * bi + ci * br; }
        gst4f(L16, L16 + (g * 64 + p) * 2, pwr[16 * 64 + p]); gst4f(L16, L16 + (g * 64 + p) * 2 + 1, pwi[16 * 64 + p]);
    }
    for (int i = tid; i < 1024; i += 512) { ccr[i] = c_re[(size_t)g * 1024 + i]; cci[i] = c_im[(size_t)g * 1024 + i]; }
    __syncthreads();
    for (int e = tid; e < 4096; e += 512) {
        const int tau = e >> 8, o = (e >> 4) & 15, i = e & 15; float acc = 0.f;
        for (int p = 0; p < 64; ++p) {
            const float cr = ccr[o * 64 + p], ci = cci[o * 64 + p], wr_ = pwr[tau * 64 + p], wi_ = pwi[tau * 64 + p];
            const float zr = cr * wr_ - ci * wi_, zi = cr * wi_ + ci * wr_;
            acc += zr * bbr[p * 16 + i] - zi * bbi[p * 16 + i];
        }
        Kt[e] = acc;
    }
    __syncthreads();
    bf16* THg = TH + (size_t)g * 256 * 384;
    for (int q = tid; q < 256 * 48; q += 512) {
        const int rowi = q / 48, ch = q % 48, t = rowi >> 4, o = rowi & 15; float v[8];
        if (ch < 32) { const int s = ch >> 1, ih = ch & 1;
#pragma unroll
            for (int e = 0; e < 8; ++e) v[e] = (s <= t) ? Kt[((t - s) * 16 + o) * 16 + ih * 8 + e] : 0.f;
        } else { const int k = (ch - 32) * 8;
#pragma unroll
            for (int e = 0; e < 8; ++e) { const int kk = k + e, p = kk & 63;
                const float cr = ccr[o * 64 + p], ci = cci[o * 64 + p], wr_ = pwr[(t + 1) * 64 + p], wi_ = pwi[(t + 1) * 64 + p];
                v[e] = (kk < 64) ? (cr * wr_ - ci * wi_) : -(cr * wi_ + ci * wr_); }
        }
        v4u w; w.x = pk2(v[0], v[1]); w.y = pk2(v[2], v[3]); w.z = pk2(v[4], v[5]); w.w = pk2(v[6], v[7]);
        gst16(TH, THg + (size_t)rowi * 384 + ch * 8, w);
    }
    bf16* GTg = GT + (size_t)g * 256 * 256;
    for (int q = tid; q < 256 * 32; q += 512) {
        const int rc = q >> 5, ch = q & 31, s = ch >> 1, ih = ch & 1, p = rc & 63; float v[8];
#pragma unroll
        for (int e = 0; e < 8; ++e) {
            if (rc < 128) { const float wr_ = pwr[(15 - s) * 64 + p], wi_ = pwi[(15 - s) * 64 + p], br = bbr[p * 16 + ih * 8 + e], bi = bbi[p * 16 + ih * 8 + e];
                v[e] = (rc < 64) ? (wr_ * br - wi_ * bi) : (wr_ * bi + wi_ * br); }
            else v[e] = 0.f;
        }
        v4u w; w.x = pk2(v[0], v[1]); w.y = pk2(v[2], v[3]); w.z = pk2(v[4], v[5]); w.w = pk2(v[6], v[7]);
        gst16(GT, GTg + (size_t)rc * 256 + ch * 8, w);
    }
    __syncthreads();
}
__device__ __forceinline__ void carry_scan(Frame& F, const float* Send, const float* L16, bf16* ug) {
    const int id = F.wave * F.G + F.vcu;
    if (id >= BATCH * NG) return;
    const int b = id / NG, g = id % NG, p = F.lane;
    const float lr = gld4f(L16, L16 + (g * 64 + p) * 2), li = gld4f(L16, L16 + (g * 64 + p) * 2 + 1);
    float xr = 0.f, xi = 0.f;
    const size_t row0 = (size_t)g * 1024 + b * 128;
    for (int c0 = 0; c0 < 128; c0 += 8) {
        float sr[8], si[8];
#pragma unroll
        for (int k = 0; k < 8; ++k) { sr[k] = gld4f(Send, Send + (row0 + c0 + k) * 128 + p); si[k] = gld4f(Send, Send + (row0 + c0 + k) * 128 + 64 + p); }
#pragma unroll
        for (int k = 0; k < 8; ++k) {
            bf16* dst = ug + (row0 + c0 + k) * 384 + 256;
            gst2(ug, dst + p, (bf16)f2bf(xr)); gst2(ug, dst + 64 + p, (bf16)f2bf(xi));
            const float nr = lr * xr - li * xi + sr[k], ni = lr * xi + li * xr + si[k];
            xr = nr; xi = ni;
        }
    }
}
__device__ __forceinline__ void rope_tables(Frame& F, const int* pos, float* ctab, float* stab) {
    const int gt = F.vcu * (NWAVES * 64) + F.tid, NT = F.G * NWAVES * 64;
    for (int e = gt; e < M * 32; e += NT) {
        const int m = e >> 5, j = e & 31;
        const float invf = __builtin_amdgcn_exp2f(-(float)(2 * j) * (13.287712379549449f / 64.0f));
        const float ang = (float)pos[m] * invf;
        gst4f(ctab, ctab + e, cosf(ang)); gst4f(stab, stab + e, sinf(ang));
    }
}
__device__ __forceinline__ void final_norm_rows(Frame& F, float* x, const float* rss, int nslot, const float* gain) {
    const int gw = F.vcu * NWAVES + F.wave, NGW = F.G * NWAVES;
#ifdef MK_DIAG
    const float diag_scale = 1.f + 2.f * (float)__hip_atomic_load((unsigned*)F.ctl + CW_CODE, __ATOMIC_RELAXED, __HIP_MEMORY_SCOPE_AGENT);
#else
    const float diag_scale = 1.f;
#endif
    f32x4 gv[4];
#pragma unroll
    for (int j = 0; j < 4; ++j) gv[j] = *((const f32x4*)gain + F.lane + 64 * j);
    for (int m = gw; m < M; m += NGW) {
        const float r = diag_scale * __builtin_amdgcn_rsqf(wave_sum(F.lane < nslot ? gld4f(rss, rss + (size_t)m * nslot + F.lane) : 0.f) * (1.f / 1024.f) + EPS);
        f32x4* xr = (f32x4*)(x + (size_t)m * D) + F.lane;
#pragma unroll
        for (int j = 0; j < 4; ++j) gst16f(x, xr + 64 * j, gld16f(x, xr + 64 * j) * gv[j] * r);
    }
}

enum Phase { PH_PRO = 0, PH_UP00, PH_DN00, PH_UCONV, PH_SEND, PH_CARRY, PH_YG, PH_GLU, PH_UP01, PH_DN01, PH_DKV, PH_UP10, PH_DN10, PH_UKV, PH_DQ, PH_UQ, PH_ATTN, PH_WO, PH_UP11, PH_DN11, PH_FIN, PH_N };
__device__ __forceinline__ bool bar_after(int p) { return !(p == PH_DKV || p == PH_UKV || p == PH_FIN); }

template <int ph> __device__ __forceinline__ void phase_body(Frame& F, const Args& args, unsigned char* ws, const XcdBarrier& bar, int hi, unsigned char* lds) {
        int tid_ = threadIdx.x, bx_ = blockIdx.x; asm volatile("" : "+v"(tid_)); asm volatile("" : "+s"(bx_));
        { unsigned long long wsi = (unsigned long long)ws; asm volatile("" : "+s"(wsi) :: "memory"); ws = (unsigned char*)(GAS unsigned char*)wsi; }
        const LAS unsigned long long* PT = (const LAS unsigned long long*)(F.lds + PT_OFF);
#define INP(k) ((const float*)(const GAS float*)rfl64(PT[k]))
#define OUTP ((float*)(GAS float*)rfl64(PT[23]))
        F.tid = tid_; F.lane = tid_ & 63; F.wave = __builtin_amdgcn_readfirstlane(tid_ >> 6);
        F.vcu = (F.G % 8 == 0) ? (bx_ % 8) * (F.G / 8) + bx_ / 8 : bx_;
        F.ctl = (gu32*)(ws + WS_CTL);
        float* rss0 = (float*)(ws + WS_RSS);
#define RSP(id) ((float*)(ws + WS_RSP + rs_off(id)))
        bf16* xb = (bf16*)(ws + WS_XB); bf16* act = (bf16*)(ws + WS_ACT);
        bf16* Win_t = (bf16*)(ws + WS_WIN); bf16* Wout_t = (bf16*)(ws + WS_WOUT);
        float* ctab = (float*)(ws + WS_ROPE); float* stab = ctab + (size_t)M * 32;
        bf16* ug = (bf16*)(ws + WS_UG); bf16* yb = (bf16*)(ws + WS_Y); float* Send = (float*)(ws + WS_SEND); float* L16 = (float*)(ws + WS_L16);
        bf16* Kn = (bf16*)(ws + WS_KN); bf16* Vb = (bf16*)(ws + WS_V); bf16* Kr = (bf16*)(ws + WS_KR); bf16* lat = (bf16*)(ws + WS_LAT); bf16* cq = (bf16*)(ws + WS_CQ);
        bf16* Qb = (bf16*)(ws + WS_Q); bf16* Ob = (bf16*)(ws + WS_O);
        LAS pg8::EpiParams* ep = (LAS pg8::EpiParams*)(F.lds + EPI_OFF);
        LAS GemmParams* gp = (LAS GemmParams*)(F.lds + GP_OFF);
        const bool t0 = (tid_ == 0);
        if (t0) { gp->is_gemm = 0; gp->bgt = 1 << 30; gp->bgbytes = 0; gp->gM = M; gp->crot = 0; gp->gsz = 0; gp->cskip = 0; ep->rss_in = nullptr; ep->rss_out = nullptr; ep->rs_lds = 0; }
#define GP_SET(A_, Bt_, lda_, ldb_, K_, gN_) do { gp->is_gemm = 1; gp->A = (A_); gp->Bt = (Bt_); gp->lda = (lda_); gp->ldb = (ldb_); gp->K = (K_); gp->gN = (gN_); } while (0)
        switch (ph) {
        case PH_PRO: {
            LAS float* scr = (LAS float*)(F.lds + RING_OFF + F.wave * 16384);
            const bool tbl_wg = (F.G == 256) && ((F.vcu & 3) == 0);
            const int gw = (F.G == 256) ? (3 * (F.vcu >> 2) + (F.vcu & 3) - 1) * NWAVES + F.wave : F.vcu * NWAVES + F.wave, NGW = (F.G == 256 ? 192 : F.G) * NWAVES;
            constexpr int I_IN = (D / 64) * (2 * FF / 32), I_OUT = (FF / 64) * (D / 32), I_GLU = 16 * 64, I_DKV = 16 * 8, I_UKV = 4 * 64, I_DQ = 16 * 8, I_UQ = 4 * 48, I_O = 16 * 32;
            constexpr int NITEMS = 4 * I_IN + 4 * I_OUT + I_GLU + I_DKV + I_UKV + I_DQ + I_UQ + I_O;
            if (tbl_wg) s5_tables(F, F.vcu >> 2, INP(5), INP(6), INP(7), INP(8), INP(9), INP(10), INP(11), (bf16*)(ws + WS_TH), (bf16*)(ws + WS_GT), L16);
            else for (int it = gw; it < NITEMS; it += NGW) {
                int r = it; ConvJob j;
                if (r < 4 * I_IN) { const int idx = r / I_IN; r -= idx * I_IN; const int l = idx >> 1, jj = idx & 1;
                    j = ConvJob{INP(3) + (size_t)idx * D * 2 * FF, 2 * FF, D, D, 2 * FF, 1, INP(2) + (size_t)(l * 3 + (jj ? 2 : 0)) * D, Win_t + (size_t)idx * 2 * FF * D, D}; }
                else if ((r -= 4 * I_IN) < 4 * I_OUT) { const int idx = r / I_OUT; r -= idx * I_OUT;
                    j = ConvJob{INP(4) + (size_t)idx * FF * D, D, FF, FF, D, 0, nullptr, Wout_t + (size_t)idx * D * FF, FF}; }
                else if ((r -= 4 * I_OUT) < I_GLU) j = ConvJob{INP(13), 2048, 1024, 1024, 2048, 2, nullptr, (bf16*)(ws + WS_WGLU), 1024};
                else if ((r -= I_GLU) < I_DKV) j = ConvJob{INP(15), 192, 1024, 1024, 256, 3, INP(14), (bf16*)(ws + WS_WDKV), 1024};
                else if ((r -= I_DKV) < I_UKV) j = ConvJob{INP(17), 2048, 128, 256, 2048, 0, INP(16), (bf16*)(ws + WS_WUKV), P256};
                else if ((r -= I_UKV) < I_DQ) j = ConvJob{INP(18), 256, 1024, 1024, 256, 0, INP(2) + (size_t)(3 + 1) * D, (bf16*)(ws + WS_WDQ), 1024};
                else if ((r -= I_DQ) < I_UQ) j = ConvJob{INP(20), 1536, 256, 256, 1536, 4, INP(19), (bf16*)(ws + WS_WUQ), P256};
                else { r -= I_UQ; j = ConvJob{INP(21), 1024, 1024, 1024, 1024, 0, nullptr, (bf16*)(ws + WS_WO), 1024}; }
                conv_job_item(j, r, scr, F.lane);
            }
            __syncthreads();
            xconv_rows(F, INP(0), xb, rss0);
            rope_tables(F, (const int*)INP(1), ctab, stab);
            if (F.G != 256 && (F.vcu & 3) == 0 && (F.vcu >> 2) < NG)
                s5_tables(F, F.vcu >> 2, INP(5), INP(6), INP(7), INP(8), INP(9), INP(10), INP(11), (bf16*)(ws + WS_TH), (bf16*)(ws + WS_GT), L16);
            { const int gt = F.vcu * (NWAVES * 64) + F.tid, NT = F.G * NWAVES * 64;
              for (int e = gt; e < M * 16; e += NT) { const int m = e >> 4, c = e & 15; gst16(lat, lat + (size_t)m * P256 + 128 + c * 8, (v4u){0u, 0u, 0u, 0u}); } }
        } break;
        case PH_UP00: case PH_UP01: case PH_UP10: case PH_UP11:
#ifdef MK_DIAG
            if (ph == PH_UP00 && hi - ph > 1 && ph > 0 || (ph == PH_UP00 && hi > 1 && ph == 1)) {
                const int m = bx_ * 64 + (tid_ >> 3), c = (tid_ & 7) * 128 + 6;
                const float* xin = INP(0);
                const unsigned want = pk2(xin[(size_t)m * D + c], xin[(size_t)m * D + c + 1]);
                const unsigned got_plain = *(const volatile unsigned*)(xb + (size_t)m * D + c);
                const unsigned got_sc1 = __hip_atomic_load((const unsigned*)(xb + (size_t)m * D + c), __ATOMIC_RELAXED, __HIP_MEMORY_SCOPE_SYSTEM);
                if (got_sc1 != want) atomicMax((unsigned*)F.ctl + CW_CODE, 3u);
                else if (got_plain != want) atomicMax((unsigned*)F.ctl + CW_CODE, 2u);
            }
#endif
#ifdef DIAG_RSSFIX
            if (ph == PH_UP01 && hi - ph > 1 && ph > 0) { rss_rows(F, OUTP, RSP(RS_X2)); GRID_BARRIER(); }
#endif
            {
            const int idx = (ph == PH_UP00) ? 0 : (ph == PH_UP01) ? 1 : (ph == PH_UP10) ? 2 : 3;
            const int rsi = (ph == PH_UP00) ? RS_X0 : (ph == PH_UP01) ? RS_X2 : (ph == PH_UP10) ? RS_X3 : RS_X5;
            const float* rsp = (rsi == RS_X0) ? rss0 : (rsi == RS_X2) ? RSP(RS_X2) : (rsi == RS_X3) ? RSP(RS_X3) : RSP(RS_X5);
            if (F.G == 256) {
                const int ns = rs_slots(rsi), r0 = (bx_ & 7) * 2048 + tid_ * 4;
                f32x4 sq = (f32x4){0.f, 0.f, 0.f, 0.f};
                if (ns == 1) sq = gld16f(rsp, rsp + r0);
                else {
#pragma unroll
                    for (int rr = 0; rr < 4; ++rr) { float a = 0.f;
                        for (int q = 0; q < ns; q += 4) { const f32x4 v = gld16f(rsp, rsp + (size_t)(r0 + rr) * ns + q); a += (v[0] + v[1]) + (v[2] + v[3]); }
                        sq[rr] = a; }
                }
                f32x4 rsv;
#pragma unroll
                for (int rr = 0; rr < 4; ++rr) rsv[rr] = __builtin_amdgcn_rsqf(sq[rr] * (1.f / 1024.f) + EPS);
                *(LAS f32x4*)(F.lds + RSL_OFF + tid_ * 16) = rsv;
            }
            if (t0) {
            GP_SET(xb, Win_t + (size_t)idx * 2 * FF * D, D, D, D, 2 * FF);
            ep->mode = pg8::EM_SWIGLU; ep->rss_n = rs_slots(rsi); ep->inv_k = 1.f / 1024.f;
            if (F.G == 256) { ep->rss_in = nullptr; ep->rs_lds = RSL_OFF - EPI_OFF; } else ep->rss_in = rsp; ep->ob = act; ep->ldo = FF;
            } }
            break;
        case PH_DN00: case PH_DN01: case PH_DN10: case PH_DN11: if (t0) {
            const int idx = (ph == PH_DN00) ? 0 : (ph == PH_DN01) ? 1 : (ph == PH_DN10) ? 2 : 3;
            const int rso = (ph == PH_DN00) ? RS_X1 : (ph == PH_DN01) ? RS_X3 : (ph == PH_DN10) ? RS_X4 : RS_X6;
            GP_SET(act, Wout_t + (size_t)idx * D * FF, FF, FF, FF, D);
            ep->mode = pg8::EM_RES; ep->base = (ph == PH_DN00) ? INP(0) : OUTP; ep->out = OUTP; ep->alpha = 0.5f; ep->ob = xb; ep->rss_out = (rso == RS_X1) ? RSP(RS_X1) : (rso == RS_X3) ? RSP(RS_X3) : (rso == RS_X4) ? RSP(RS_X4) : RSP(RS_X6);
        } break;
        case PH_UCONV: uconv_rows(F, OUTP, RSP(RS_X1), rs_slots(RS_X1), INP(2) + 1 * D, ug); break;
        case PH_SEND: if (t0) {
            GP_SET(ug, (const bf16*)(ws + WS_GT), 384, 256, 256, 256); gp->gM = NG * 1024; gp->bgt = 4; gp->bgbytes = (size_t)256 * 256 * 2;
            ep->mode = pg8::EM_SEND; ep->fout = Send;
        } break;
        case PH_CARRY: carry_scan(F, Send, L16, ug); break;
        case PH_YG: if (t0) {
            GP_SET(ug, (const bf16*)(ws + WS_TH), 384, 384, 384, 256); gp->gM = NG * 1024; gp->bgt = 4; gp->bgbytes = (size_t)256 * 384 * 2;
            ep->mode = pg8::EM_Y; ep->ua = ug; ep->aux0 = INP(12); ep->ob = yb;
        } break;
        case PH_GLU: if (t0) {
            GP_SET(yb, (const bf16*)(ws + WS_WGLU), D, D, D, 2048);
            ep->mode = pg8::EM_GLU; ep->base = OUTP; ep->out = OUTP; ep->ob = xb; ep->rss_out = RSP(RS_X2);
        } break;
        case PH_DKV: if (t0) {
            GP_SET(xb, (const bf16*)(ws + WS_WDKV), D, D, D, 256); gp->crot = 128;
            ep->mode = pg8::EM_DKV; ep->rss_in = RSP(RS_X3); ep->rss_n = rs_slots(RS_X3); ep->inv_k = 1.f / 1024.f; ep->ob = lat; ep->ob2 = Kr; ep->rss_out = RSP(RS_LAT); ep->aux0 = ctab; ep->aux1 = stab;
        } break;
        case PH_UKV: if (t0) {
            GP_SET(lat, (const bf16*)(ws + WS_WUKV), P256, P256, 256, 2048); if (F.G == 256) { gp->gsz = 192; gp->cskip = 64; }
            ep->mode = pg8::EM_UKV; ep->rss_in = RSP(RS_LAT); ep->rss_n = rs_slots(RS_LAT); ep->inv_k = 1.f / 128.f; ep->ob = Kn; ep->ob2 = Vb;
        } break;
        case PH_DQ: if (t0) {
            GP_SET(xb, (const bf16*)(ws + WS_WDQ), D, D, D, 256);
            ep->mode = pg8::EM_DQ; ep->rss_in = RSP(RS_X4); ep->rss_n = rs_slots(RS_X4); ep->inv_k = 1.f / 1024.f; ep->ob = cq; ep->rss_out = RSP(RS_Q);
        } break;
        case PH_UQ: if (t0) {
            GP_SET(cq, (const bf16*)(ws + WS_WUQ), P256, P256, 256, 1536);
            ep->mode = pg8::EM_UQ; ep->rss_in = RSP(RS_Q); ep->rss_n = rs_slots(RS_Q); ep->inv_k = 1.f / 256.f; ep->ob = Qb; ep->alpha = QSCALE; ep->aux0 = ctab; ep->aux1 = stab;
        } break;
        case PH_ATTN: attn::attn_phase((char*)lds + RING_OFF, Qb, Kn, Kr, Vb, Ob, F.vcu, F.G, tid_); break;
        case PH_WO: if (t0) {
            GP_SET(Ob, (const bf16*)(ws + WS_WO), D, D, D, D);
            ep->mode = pg8::EM_RES; ep->base = OUTP; ep->out = OUTP; ep->alpha = 1.0f; ep->ob = xb; ep->rss_out = RSP(RS_X5);
        } break;
        case PH_FIN: final_norm_rows(F, OUTP, RSP(RS_X6), rs_slots(RS_X6), INP(22)); break;
        default: break;
        }
#undef GP_SET
#undef INP
#undef OUTP
        __syncthreads();
        if (__builtin_amdgcn_readfirstlane(gp->is_gemm)) {
            pg8::Gemm g;
            g.A = (const bf16*)(const GAS bf16*)rfl64((unsigned long long)gp->A); g.Bt = (const bf16*)(const GAS bf16*)rfl64((unsigned long long)gp->Bt);
            g.lda = __builtin_amdgcn_readfirstlane(gp->lda); g.ldb = __builtin_amdgcn_readfirstlane(gp->ldb); g.K = __builtin_amdgcn_readfirstlane(gp->K);
            g.bgt = __builtin_amdgcn_readfirstlane(gp->bgt); g.bgbytes = (size_t)rfl64((unsigned long long)gp->bgbytes);
            const int gM = __builtin_amdgcn_readfirstlane(gp->gM), gN = __builtin_amdgcn_readfirstlane(gp->gN), crot = __builtin_amdgcn_readfirstlane(gp->crot);
            const int gsz = __builtin_amdgcn_readfirstlane(gp->gsz), cskip = __builtin_amdgcn_readfirstlane(gp->cskip);
            const int cc = (int)((bx_ + crot) % F.G) - cskip;
            if (cc >= 0) {
                pg8::StaticOrder S; S.init(gM, gN, gsz ? gsz : F.G, cc);
                pg8::EpiDyn ED{(const LAS pg8::EpiParams*)(F.lds + EPI_OFF)};
                pg8::gemm_phase<pg8::EpiDyn, pg8::StaticOrder, true, true>(F.lds + RING_OFF, g, S, ED, tid_);
            }
        }
        if (ph + 1 < hi && bar_after(ph)) { GRID_BARRIER();
#ifdef DUP_BAR
            GRID_BARRIER();
#endif
        }
        __syncthreads();
}

__global__ void __launch_bounds__(NWAVES * 64, 2) mk_fwd(Args args) {
    extern __shared__ __attribute__((aligned(16))) unsigned char lds[];
    Frame F;
    F.lds = (LAS unsigned char*)lds;
    F.MISC = (volatile LAS unsigned*)(F.lds + MISC_OFF);
    F.tid = threadIdx.x; F.lane = F.tid & 63; F.wave = __builtin_amdgcn_readfirstlane(F.tid >> 6);
    F.G = gridDim.x; { const int bx = blockIdx.x; F.vcu = (F.G % 8 == 0) ? (bx % 8) * (F.G / 8) + bx / 8 : bx; }
    unsigned char* ws = args.ws;
    F.ctl = (gu32*)(ws + WS_CTL);
    for (int u = F.tid; u < (LDS_BYTES - LDSCTL_OFF) / 4; u += NWAVES * 64) ((LAS unsigned*)(F.lds + LDSCTL_OFF))[u] = 0u;
    __syncthreads();
    if (F.tid == 0) { LAS unsigned long long* pt = (LAS unsigned long long*)(F.lds + PT_OFF);
        pt[0] = (unsigned long long)args.in[0];
        pt[1] = (unsigned long long)args.in[1];
        pt[2] = (unsigned long long)args.in[2];
        pt[3] = (unsigned long long)args.in[3];
        pt[4] = (unsigned long long)args.in[4];
        pt[5] = (unsigned long long)args.in[5];
        pt[6] = (unsigned long long)args.in[6];
        pt[7] = (unsigned long long)args.in[7];
        pt[8] = (unsigned long long)args.in[8];
        pt[9] = (unsigned long long)args.in[9];
        pt[10] = (unsigned long long)args.in[10];
        pt[11] = (unsigned long long)args.in[11];
        pt[12] = (unsigned long long)args.in[12];
        pt[13] = (unsigned long long)args.in[13];
        pt[14] = (unsigned long long)args.in[14];
        pt[15] = (unsigned long long)args.in[15];
        pt[16] = (unsigned long long)args.in[16];
        pt[17] = (unsigned long long)args.in[17];
        pt[18] = (unsigned long long)args.in[18];
        pt[19] = (unsigned long long)args.in[19];
        pt[20] = (unsigned long long)args.in[20];
        pt[21] = (unsigned long long)args.in[21];
        pt[22] = (unsigned long long)args.in[22];
        pt[23] = (unsigned long long)args.out; }
    __syncthreads();
    XcdBarrier bar; bar.bar = (unsigned*)(F.ctl + CW_BAR) + args.li * XCD_BAR_WORDS; bar.x = 0; bar.st = nullptr;
    const int lo = args.ph_lo, hi = args.ph_hi;
#ifdef MK_SIMPLE_BAR
    if (hi - lo > 1) sb_begin((unsigned*)F.ctl);
#else
    if (hi - lo > 1) bar = xcd_barrier_post((unsigned*)(F.ctl + CW_BAR) + args.li * XCD_BAR_WORDS, F.MISC + 8);
#endif


    if (lo <= 0 && 0 < hi) { phase_body<0>(F, args, ws, bar, hi, lds);
#if defined(DUP_PH) && DUP_PH == 0
        phase_body<0>(F, args, ws, bar, hi, lds);
#endif
    }
    if (lo <= 1 && 1 < hi) { phase_body<1>(F, args, ws, bar, hi, lds);
#if defined(DUP_PH) && DUP_PH == 1
        phase_body<1>(F, args, ws, bar, hi, lds);
#endif
    }
    if (lo <= 2 && 2 < hi) { phase_body<2>(F, args, ws, bar, hi, lds);
#if defined(DUP_PH) && DUP_PH == 2
        phase_body<2>(F, args, ws, bar, hi, lds);
#endif
    }
    if (lo <= 3 && 3 < hi) { phase_body<3>(F, args, ws, bar, hi, lds);
#if defined(DUP_PH) && DUP_PH == 3
        phase_body<3>(F, args, ws, bar, hi, lds);
#endif
    }
    if (lo <= 4 && 4 < hi) { phase_body<4>(F, args, ws, bar, hi, lds);
#if defined(DUP_PH) && DUP_PH == 4
        phase_body<4>(F, args, ws, bar, hi, lds);
#endif
    }
    if (lo <= 5 && 5 < hi) { phase_body<5>(F, args, ws, bar, hi, lds);
#if defined(DUP_PH) && DUP_PH == 5
        phase_body<5>(F, args, ws, bar, hi, lds);
#endif
    }
    if (lo <= 6 && 6 < hi) { phase_body<6>(F, args, ws, bar, hi, lds);
#if defined(DUP_PH) && DUP_PH == 6
        phase_body<6>(F, args, ws, bar, hi, lds);
#endif
#if defined(DUP_S5)
        phase_body<3>(F, args, ws, bar, hi, lds); phase_body<4>(F, args, ws, bar, hi, lds); phase_body<5>(F, args, ws, bar, hi, lds); phase_body<6>(F, args, ws, bar, hi, lds);
#endif
    }
    if (lo <= 7 && 7 < hi) { phase_body<7>(F, args, ws, bar, hi, lds);
#if defined(DUP_PH) && DUP_PH == 7
        phase_body<7>(F, args, ws, bar, hi, lds);
#endif
    }
    if (lo <= 8 && 8 < hi) { phase_body<8>(F, args, ws, bar, hi, lds);
#if defined(DUP_PH) && DUP_PH == 8
        phase_body<8>(F, args, ws, bar, hi, lds);
#endif
    }
    if (lo <= 9 && 9 < hi) { phase_body<9>(F, args, ws, bar, hi, lds);
#if defined(DUP_PH) && DUP_PH == 9
        phase_body<9>(F, args, ws, bar, hi, lds);
#endif
    }
    if (lo <= 10 && 10 < hi) { phase_body<10>(F, args, ws, bar, hi, lds);
#if defined(DUP_PH) && DUP_PH == 10
        phase_body<10>(F, args, ws, bar, hi, lds);
#endif
    }
    if (lo <= 11 && 11 < hi) { phase_body<11>(F, args, ws, bar, hi, lds);
#if defined(DUP_PH) && DUP_PH == 11
        phase_body<11>(F, args, ws, bar, hi, lds);
#endif
    }
    if (lo <= 12 && 12 < hi) { phase_body<12>(F, args, ws, bar, hi, lds);
#if defined(DUP_PH) && DUP_PH == 12
        phase_body<12>(F, args, ws, bar, hi, lds);
#endif
    }
    if (lo <= 13 && 13 < hi) { phase_body<13>(F, args, ws, bar, hi, lds);
#if defined(DUP_PH) && DUP_PH == 13
        phase_body<13>(F, args, ws, bar, hi, lds);
#endif
    }
    if (lo <= 14 && 14 < hi) { phase_body<14>(F, args, ws, bar, hi, lds);
#if defined(DUP_PH) && DUP_PH == 14
        phase_body<14>(F, args, ws, bar, hi, lds);
#endif
    }
    if (lo <= 15 && 15 < hi) { phase_body<15>(F, args, ws, bar, hi, lds);
#if defined(DUP_PH) && DUP_PH == 15
        phase_body<15>(F, args, ws, bar, hi, lds);
#endif
    }
    if (lo <= 16 && 16 < hi) { phase_body<16>(F, args, ws, bar, hi, lds);
#if defined(DUP_PH) && DUP_PH == 16
        phase_body<16>(F, args, ws, bar, hi, lds);
#endif
    }
    if (lo <= 17 && 17 < hi) { phase_body<17>(F, args, ws, bar, hi, lds);
#if defined(DUP_PH) && DUP_PH == 17
        phase_body<17>(F, args, ws, bar, hi, lds);
#endif
    }
    if (lo <= 18 && 18 < hi) { phase_body<18>(F, args, ws, bar, hi, lds);
#if defined(DUP_PH) && DUP_PH == 18
        phase_body<18>(F, args, ws, bar, hi, lds);
#endif
    }
    if (lo <= 19 && 19 < hi) { phase_body<19>(F, args, ws, bar, hi, lds);
#if defined(DUP_PH) && DUP_PH == 19
        phase_body<19>(F, args, ws, bar, hi, lds);
#endif
    }
    if (lo <= 20 && 20 < hi) { phase_body<20>(F, args, ws, bar, hi, lds);
#if defined(DUP_PH) && DUP_PH == 20
        phase_body<20>(F, args, ws, bar, hi, lds);
#endif
    }
#ifdef MK_SIMPLE_BAR
    if (hi - lo > 1) sb_end((unsigned*)F.ctl);
#endif
}

__global__ void __launch_bounds__(256) dg_cksum(const unsigned* p, size_t nwords, unsigned long long* out, int slot) {
    if (blockIdx.x == 0 && threadIdx.x == 0 && slot < 0) { out[0] = 0; out[1] = 0; }
    if (slot < 0) return;
    unsigned long long s = 0;
    for (size_t i = (size_t)blockIdx.x * 256 + threadIdx.x; i < nwords; i += (size_t)gridDim.x * 256) s += (unsigned long long)p[i] * (unsigned long long)(2 * (i & 0xffff) + 1);
    for (int o = 1; o < 64; o <<= 1) s += __shfl_xor(s, o);
    if ((threadIdx.x & 63) == 0) atomicAdd(out + slot, s);
}
__global__ void __launch_bounds__(256) dg_fill(unsigned* p, size_t nwords, unsigned pat) {
    for (size_t i = (size_t)blockIdx.x * 256 + threadIdx.x; i < nwords; i += (size_t)gridDim.x * 256) p[i] = pat;
}
__global__ void dg_cmp(const unsigned long long* c, unsigned* code) { if (threadIdx.x == 0) code[0] = (c[0] != c[1]) ? 1u : 0u; }
__global__ void __launch_bounds__(256) dg_nan_if(const unsigned long long* c, float* out, size_t n) {
    if (c[0] == c[1]) return;
    for (size_t i = (size_t)blockIdx.x * 256 + threadIdx.x; i < n; i += (size_t)gridDim.x * 256) out[i] = __builtin_nanf("");
}

extern "C" void kernel_launch(void* const* d_in, const int* in_sizes, int n_in, void* d_out, int out_size, void* d_ws, size_t ws_size, hipStream_t stream) {
    static int grid = 0;
    if (grid == 0) {
        if (n_in != 23 || in_sizes[0] != M * D || out_size != M * D || ws_size < WS_END) { fprintf(stderr, "kernel_launch: unexpected shapes / workspace (%d inputs, ws %zu)\n", n_in, ws_size); grid = -1; return; }
        int dev = 0, cus = 0;
        if (hipGetDevice(&dev) != hipSuccess || hipDeviceGetAttribute(&cus, hipDeviceAttributeMultiprocessorCount, dev) != hipSuccess) { grid = -1; return; }
        if (hipFuncSetAttribute((const void*)mk_fwd, hipFuncAttributeMaxDynamicSharedMemorySize, LDS_BYTES) != hipSuccess) { fprintf(stderr, "kernel_launch: hipFuncSetAttribute failed\n"); grid = -1; return; }
        int per_cu = 0;
        if (hipOccupancyMaxActiveBlocksPerMultiprocessor(&per_cu, (const void*)mk_fwd, NWAVES * 64, LDS_BYTES) != hipSuccess || per_cu < 1) fprintf(stderr, "kernel_launch: occupancy query says %d\n", per_cu);
        (void)hipGetLastError();
        grid = cus;
    }
    if (grid < 0) return;
    if (hipMemsetAsync((char*)d_ws + WS_CTL, 0, CTL_ZERO_BYTES, stream) != hipSuccess) return;
    Args a{};
    for (int i = 0; i < 23; ++i) a.in[i] = (const float*)d_in[i];
    a.out = (float*)d_out; a.ws = (unsigned char*)d_ws;
#if MK_MODE == 0
    a.ph_lo = 0; a.ph_hi = PH_N; a.li = 0;
    hipLaunchKernelGGL(mk_fwd, dim3(grid), dim3(NWAVES * 64), LDS_BYTES, stream, a);
#elif MK_MODE == 1
    for (int p = 0; p < PH_N; ++p) { a.ph_lo = p; a.ph_hi = p + 1; a.li = 0; hipLaunchKernelGGL(mk_fwd, dim3(grid), dim3(NWAVES * 64), LDS_BYTES, stream, a); }
#elif MK_MODE == 4
    unsigned long long* ck = (unsigned long long*)((char*)d_ws + WS_CTL + 512 * 1024);
    hipLaunchKernelGGL(dg_cksum, dim3(1), dim3(256), 0, stream, (const unsigned*)nullptr, (size_t)0, ck, -1);
    for (int pass = 0; pass < 2; ++pass) {
        hipLaunchKernelGGL(dg_fill, dim3(4096), dim3(256), 0, stream, (unsigned*)((char*)d_ws + 1 * MiB), (size_t)(WS_END - 1 * MiB) / 4, pass ? 0x33333333u : 0x55555555u);
        hipLaunchKernelGGL(dg_fill, dim3(4096), dim3(256), 0, stream, (unsigned*)d_out, (size_t)M * D, pass ? 0x77777777u : 0x11111111u);
        for (int p = 0; p < PH_N; ) {
            if (p == MK_CUT_LO) { a.ph_lo = MK_CUT_LO; a.ph_hi = MK_CUT_HI; p = MK_CUT_HI; } else { a.ph_lo = p; a.ph_hi = p + 1; ++p; }
            a.li = 0; hipLaunchKernelGGL(mk_fwd, dim3(grid), dim3(NWAVES * 64), LDS_BYTES, stream, a);
            if (a.ph_hi - a.ph_lo > 1) (void)hipMemsetAsync((char*)d_ws + WS_CTL + CW_BAR * 4, 0, XCD_BAR_WORDS * 4, stream);
        }
        hipLaunchKernelGGL(dg_cksum, dim3(1024), dim3(256), 0, stream, (const unsigned*)d_out, (size_t)M * D, ck, pass);
    }
    hipLaunchKernelGGL(dg_nan_if, dim3(1024), dim3(256), 0, stream, (const unsigned long long*)ck, (float*)d_out, (size_t)M * D);
#elif MK_MODE == 3
    unsigned long long* ck = (unsigned long long*)((char*)d_ws + WS_CTL + 512 * 1024);
    unsigned* code = (unsigned*)((char*)d_ws + WS_CTL) + CW_CODE;
    hipLaunchKernelGGL(dg_cksum, dim3(1), dim3(256), 0, stream, (const unsigned*)nullptr, (size_t)0, ck, -1);
    for (int p = MK_CUT_LO; p < MK_CUT_HI; ++p) { a.ph_lo = p; a.ph_hi = p + 1; hipLaunchKernelGGL(mk_fwd, dim3(grid), dim3(NWAVES * 64), LDS_BYTES, stream, a); }
    hipLaunchKernelGGL(dg_cksum, dim3(1024), dim3(256), 0, stream, (const unsigned*)((char*)d_ws + WS_ACT), (size_t)M * FF / 2, ck, 0);
#if defined(DG_SCRAMBLE) && DG_SCRAMBLE == 1
    hipLaunchKernelGGL(dg_fill, dim3(2048), dim3(256), 0, stream, (unsigned*)((char*)d_ws + WS_XB), (size_t)M * D / 2, 0x3f803f80u);
#elif defined(DG_SCRAMBLE) && DG_SCRAMBLE == 2
    hipLaunchKernelGGL(dg_fill, dim3(2048), dim3(256), 0, stream, (unsigned*)((char*)d_ws + WS_WIN), (size_t)2 * FF * D / 2, 0x3c003c00u);
#elif defined(DG_SCRAMBLE) && DG_SCRAMBLE == 3
    hipLaunchKernelGGL(dg_fill, dim3(64), dim3(256), 0, stream, (unsigned*)((char*)d_ws + WS_RSS), (size_t)M, 0x44800000u);
#endif
    a.ph_lo = MK_CUT_LO; a.ph_hi = MK_CUT_HI; hipLaunchKernelGGL(mk_fwd, dim3(grid), dim3(NWAVES * 64), LDS_BYTES, stream, a);
    hipLaunchKernelGGL(dg_cksum, dim3(1024), dim3(256), 0, stream, (const unsigned*)((char*)d_ws + WS_ACT), (size_t)M * FF / 2, ck, 1);
    hipLaunchKernelGGL(dg_cmp, dim3(1), dim3(64), 0, stream, (const unsigned long long*)ck, code);
    for (int p = MK_CUT_HI; p < PH_N; ++p) { a.ph_lo = p; a.ph_hi = p + 1; hipLaunchKernelGGL(mk_fwd, dim3(grid), dim3(NWAVES * 64), LDS_BYTES, stream, a); }
#else
    for (int p = 0; p < PH_N; ) {
        if (p == MK_CUT_LO) { a.ph_lo = MK_CUT_LO; a.ph_hi = MK_CUT_HI; p = MK_CUT_HI; } else { a.ph_lo = p; a.ph_hi = p + 1; ++p; }
        a.li = 0; hipLaunchKernelGGL(mk_fwd, dim3(grid), dim3(NWAVES * 64), LDS_BYTES, stream, a);
        if (a.ph_hi - a.ph_lo > 1 && p < PH_N) (void)hipMemsetAsync((char*)d_ws + WS_CTL + CW_BAR * 4, 0, XCD_BAR_WORDS * 4, stream);
    }
#endif
}
```

```cpp
#include <hip/hip_runtime.h>
#include <hip/hip_bf16.h>
#include <cstdio>
#include <cstdint>
#include <cmath>

#ifndef MK_MODE
#define MK_MODE 0
#endif
#ifndef MK_CUT_LO
#define MK_CUT_LO 0
#define MK_CUT_HI 2
#endif

constexpr int BATCH = 8, SEQ = 2048, D = 1024, M = BATCH * SEQ, FF = 2816, NG = 64, NP = 64, NH = 8;
constexpr float EPS = 1e-6f;
constexpr float QSCALE = 0.07216878364870323f * 1.4426950408889634f;
constexpr int NWAVES = 8;
constexpr int P256 = 320;

constexpr size_t MiB = 1u << 20;
constexpr size_t WS_CTL = 0, CTL_ZERO_BYTES = 65536;
constexpr size_t WS_RSS = 1 * MiB;
constexpr size_t WS_WIN = 2 * MiB;
constexpr size_t WIN_BYTES = (size_t)2 * FF * D * 2;
constexpr size_t WS_WOUT = WS_WIN + 4 * WIN_BYTES;
constexpr size_t WOUT_BYTES = (size_t)D * FF * 2;
constexpr size_t WS_WGLU = WS_WOUT + 4 * WOUT_BYTES;
constexpr size_t WS_WDKV = WS_WGLU + (size_t)2048 * 1024 * 2;
constexpr size_t WS_WUKV = WS_WDKV + (size_t)256 * 1024 * 2;
constexpr size_t WS_WDQ = WS_WUKV + (size_t)2048 * P256 * 2;
constexpr size_t WS_WUQ = WS_WDQ + (size_t)256 * 1024 * 2;
constexpr size_t WS_WO = WS_WUQ + (size_t)1536 * P256 * 2;
constexpr size_t WS_WEND = WS_WO + (size_t)1024 * 1024 * 2;
static_assert(WS_WEND <= 78 * MiB, "weights");
constexpr size_t WS_TH = 78 * MiB;
constexpr size_t WS_GT = 90 * MiB;
constexpr size_t WS_ROPE = 98 * MiB;
constexpr size_t WS_L16 = 256 * 1024;
constexpr size_t WS_XB = 102 * MiB;
constexpr size_t WS_ACT = 134 * MiB;
constexpr size_t WS_Q = WS_ACT, WS_O = WS_ACT + 48 * MiB;
constexpr size_t WS_R2 = 222 * MiB;
constexpr size_t WS_UG = WS_R2, WS_Y = WS_R2 + 48 * MiB, WS_SEND = WS_R2 + 80 * MiB;
constexpr size_t WS_KN = WS_R2, WS_V = WS_R2 + 32 * MiB, WS_KR = WS_R2 + 64 * MiB, WS_LAT = WS_R2 + 66 * MiB, WS_CQ = WS_R2 + 78 * MiB;
constexpr size_t WS_RSP = 334 * MiB;
constexpr size_t WS_END = 342 * MiB;
static_assert(WS_ROPE + (size_t)M * 32 * 4 * 2 <= WS_XB && WS_L16 >= CTL_ZERO_BYTES && WS_L16 + 32768 <= 512 * 1024, "rope tables / l16 placement");

constexpr int CW_TMO = 0, CW_CODE = 1, CW_BAR = 4096;
enum { RS_X0 = 0, RS_X1, RS_X2, RS_X3, RS_X4, RS_X5, RS_X6, RS_LAT, RS_Q, RS_N };
__host__ __device__ constexpr int rs_slots(int id) { return id == RS_X0 ? 1 : id == RS_X2 ? 32 : (id == RS_LAT || id == RS_Q) ? 4 : 16; }
__host__ __device__ constexpr size_t rs_off(int id) { size_t o = 0; for (int i = 1; i < id; ++i) o += (size_t)M * rs_slots(i) * 4; return o; }
static_assert(rs_off(RS_N) <= 8 * MiB, "partial-sum arrays");

constexpr int RING_OFF = 0, RING_BYTES = 131072;
constexpr int LDSCTL_OFF = RING_BYTES, MISC_OFF = LDSCTL_OFF + 320;
constexpr int EPI_OFF = MISC_OFF + 128, GP_OFF = EPI_OFF + 128, PT_OFF = GP_OFF + 80;
constexpr int RSL_OFF = (PT_OFF + 24 * 8 + 15) / 16 * 16;
constexpr int LDS_BYTES = 147456;
static_assert(RSL_OFF + 8192 <= LDS_BYTES, "row-scale table");

#define GAS __attribute__((address_space(1)))
#define LAS __attribute__((address_space(3)))
typedef unsigned short bf16;
typedef unsigned v4u __attribute__((ext_vector_type(4)));
typedef unsigned v2u __attribute__((ext_vector_type(2)));
typedef float f32x4 __attribute__((ext_vector_type(4)));
typedef float f32x2 __attribute__((ext_vector_type(2)));
typedef short bf16x8 __attribute__((ext_vector_type(8)));
typedef GAS unsigned gu32;
#define RLX_AGENT __ATOMIC_RELAXED, __HIP_MEMORY_SCOPE_AGENT
#define LDS_WAIT() asm volatile("s_waitcnt lgkmcnt(0)" ::: "memory")
#define VM_WAIT() asm volatile("s_waitcnt vmcnt(0)" ::: "memory")
typedef _Float16 h16x2 __attribute__((ext_vector_type(2)));
typedef _Float16 h16x8 __attribute__((ext_vector_type(8)));
__device__ __forceinline__ unsigned f2bf(float f) { return (unsigned)__builtin_bit_cast(unsigned short, (_Float16)f); }
__device__ __forceinline__ unsigned pk2(float lo, float hi) { const h16x2 v = {(_Float16)lo, (_Float16)hi}; return __builtin_bit_cast(unsigned, v); }
__device__ __forceinline__ float bf2f(unsigned h) { return (float)__builtin_bit_cast(_Float16, (unsigned short)h); }
__device__ __forceinline__ float wave_sum(float v) {
#pragma unroll
    for (int o = 1; o < 64; o <<= 1) v += __shfl_xor(v, o);
    return v;
}


#ifdef MK_BYPASS
typedef __amdgpu_buffer_rsrc_t brs_t;
#define AUXS 17
__device__ __forceinline__ brs_t mkb(const void* p) {
    const unsigned long long v = (unsigned long long)p; const unsigned lo = __builtin_amdgcn_readfirstlane((unsigned)v), hi = __builtin_amdgcn_readfirstlane((unsigned)(v >> 32));
    return __builtin_amdgcn_make_buffer_rsrc((void*)(((unsigned long long)hi << 32) | lo), 0, 0x7fffffff, 0x00020000); }
__device__ __forceinline__ unsigned boff(const void* base, const void* p) { return (unsigned)((const char*)p - (const char*)base); }
__device__ __forceinline__ v4u gld16(const void* base, const void* p) { return __builtin_amdgcn_raw_buffer_load_b128(mkb(base), boff(base, p), 0, AUXS); }
__device__ __forceinline__ unsigned gld4(const void* base, const void* p) { return __builtin_amdgcn_raw_buffer_load_b32(mkb(base), boff(base, p), 0, AUXS); }
__device__ __forceinline__ void gst16(void* base, void* p, v4u v) { __builtin_amdgcn_raw_buffer_store_b128(v, mkb(base), boff(base, p), 0, AUXS); }
__device__ __forceinline__ void gst8(void* base, void* p, v2u v) { __builtin_amdgcn_raw_buffer_store_b64(v, mkb(base), boff(base, p), 0, AUXS); }
__device__ __forceinline__ void gst4(void* base, void* p, unsigned v) { __builtin_amdgcn_raw_buffer_store_b32(v, mkb(base), boff(base, p), 0, AUXS); }
__device__ __forceinline__ void gst2(void* base, void* p, unsigned short v) { __builtin_amdgcn_raw_buffer_store_b16(v, mkb(base), boff(base, p), 0, AUXS); }
#else
__device__ __forceinline__ v4u gld16(const void*, const void* p) { return *(const GAS v4u*)(unsigned long long)p; }
__device__ __forceinline__ unsigned gld4(const void*, const void* p) { return *(const GAS unsigned*)(unsigned long long)p; }
__device__ __forceinline__ void gst16(void*, void* p, v4u v) { *(GAS v4u*)(unsigned long long)p = v; }
__device__ __forceinline__ void gst8(void*, void* p, v2u v) { *(GAS v2u*)(unsigned long long)p = v; }
__device__ __forceinline__ void gst4(void*, void* p, unsigned v) { *(GAS unsigned*)(unsigned long long)p = v; }
__device__ __forceinline__ void gst2(void*, void* p, unsigned short v) { *(GAS unsigned short*)(unsigned long long)p = v; }
#endif
__device__ __forceinline__ f32x4 gld16f(const void* base, const void* p) { return __builtin_bit_cast(f32x4, gld16(base, p)); }
__device__ __forceinline__ float gld4f(const void* base, const void* p) { return __builtin_bit_cast(float, gld4(base, p)); }
__device__ __forceinline__ void gst16f(void* base, void* p, f32x4 v) { gst16(base, p, __builtin_bit_cast(v4u, v)); }
__device__ __forceinline__ void gst4f(void* base, void* p, float v) { gst4(base, p, __builtin_bit_cast(unsigned, v)); }

#ifdef DG_LDSDMA_AUX
#define PG8_AUX DG_LDSDMA_AUX
#else
#define PG8_AUX 0
#endif
namespace pg8 {
#define PG8_LAS __attribute__((address_space(3)))
typedef unsigned short bf16_t;
typedef short bf16x8 __attribute__((ext_vector_type(8)));
typedef float f32x4 __attribute__((ext_vector_type(4)));
typedef unsigned u32x4 __attribute__((ext_vector_type(4)));
constexpr int BM = 256, BK = 64, HALF = 128, HTB = HALF * BK * 2, STAGE_BYTES = 8 * HTB, NXCD = 8, WGM = 8;
__host__ __device__ __forceinline__ int lds_byte(int r, int c) { const int st = (r >> 4) * 2 + (c >> 5), rr = r & 15, cc = c & 31, ob = rr * 64 + cc * 2; return st * 1024 + (ob ^ (((ob >> 9) & 1) << 5)); }
__host__ __device__ __forceinline__ void stage_rc(int b, int& R, int& C) { const int st = b / 1024, sb = b % 1024, swz = sb ^ (((sb >> 9) & 1) << 5); R = (st >> 1) * 16 + swz / 64; C = (st & 1) * 32 + (swz % 64) / 2; }
__host__ __device__ __forceinline__ int perm32(int rho) { const int n = rho >> 4, i = rho & 15; return 8 * (i >> 2) + 4 * n + (i & 3); }
struct Unit { int pm, pn; };
struct Gemm { const bf16_t* A; const bf16_t* Bt; int lda, ldb, K, bgt; size_t bgbytes; };
struct StaticOrder {
    int nM, nN, nwg, G, c;
    __host__ __device__ void init(int M_, int N_, int G_, int c_) { nM = M_ / BM; nN = N_ / BM; nwg = nM * nN; G = G_; c = c_; }
    __host__ __device__ bool next(int i, Unit& u) const {
        const long L = (long)i * G + c; if (L >= nwg) return false;
        int wgid = (int)L; { const int q = nwg / NXCD, r = nwg % NXCD, xcd = wgid % NXCD, off = wgid / NXCD; wgid = (xcd < r ? xcd * (q + 1) : r * (q + 1) + (xcd - r) * q) + off; }
        const int nig = WGM * nN, gid = wgid / nig, fm = gid * WGM, gsz = (nM - fm) < WGM ? (nM - fm) : WGM;
        u.pm = fm + ((wgid % nig) % gsz); u.pn = (wgid % nig) / gsz; return true;
    }
    __device__ __forceinline__ void a_ready(const Unit&) const {}
    __device__ __forceinline__ void done(const Unit&) const {}
};
__device__ __forceinline__ unsigned cvt_pk_bf16(float lo, float hi) { return pk2(lo, hi); }

enum EpiMode { EM_SWIGLU = 0, EM_RES, EM_GLU, EM_DKV, EM_UKV, EM_DQ, EM_UQ, EM_SEND, EM_Y };
__device__ __forceinline__ float fast_sigmoid(float x) { return __builtin_amdgcn_rcpf(1.f + __builtin_amdgcn_exp2f(-1.4426950408889634f * x)); }
__device__ __forceinline__ float gelu_tanh_f(float x) {
    const float u = 0.7978845608028654f * (x + 0.044715f * x * x * x);
    return x * fast_sigmoid(2.f * u);
}
struct EpiParams {
    int mode; float inv_k; float alpha; int ldo; int rss_n; int rs_lds;
    const float* rss_in;
    float* rss_out;
    const float* base; float* out;
    bf16_t* ob;
    bf16_t* ob2;
    const float* aux0; const float* aux1;
    const bf16_t* ua;
    float* fout;
};
struct EpiDyn {
    static constexpr bool PERM = true, AFTER_DRAIN = false;
    const PG8_LAS EpiParams* P;
    __device__ __forceinline__ void operator()(const f32x4 (&acc)[2][2][4][2], const Unit& u, int wr, int wc, int fr, int fq) const {
        const int mode = P->mode; const float inv_k = P->inv_k, alpha = P->alpha; const int ldo = P->ldo, rss_n = P->rss_n, rs_lds = P->rs_lds;
#define PG8_G(T, x) ((T*)(__attribute__((address_space(1))) T*)(unsigned long long)(x))
        const float* rss_in = PG8_G(const float, P->rss_in); float* rss_out = PG8_G(float, P->rss_out); const float* base = PG8_G(const float, P->base); float* out = PG8_G(float, P->out);
        bf16_t* ob = PG8_G(bf16_t, P->ob); bf16_t* ob2 = PG8_G(bf16_t, P->ob2);
        const float* aux0 = PG8_G(const float, P->aux0); const float* aux1 = PG8_G(const float, P->aux1); const bf16_t* ua = PG8_G(const bf16_t, P->ua); float* fout = PG8_G(float, P->fout);
#undef PG8_G
#pragma unroll
        for (int ai = 0; ai < 2; ++ai)
#pragma unroll
            for (int m = 0; m < 4; ++m) {
                const int row = u.pm * BM + ai * HALF + wr * 64 + m * 16 + fr;
                float rs = 1.f;
                if (rs_lds) rs = ((const PG8_LAS float*)((const PG8_LAS char*)P + rs_lds))[row & 2047];
                else if (rss_in) {
                    float sq;
                    if (rss_n == 1) sq = gld4f(rss_in, rss_in + row);
                    else { const float* q = rss_in + (size_t)row * rss_n + fq * (rss_n >> 2);
                        if (rss_n == 4) sq = gld4f(rss_in, q);
                        else if (rss_n == 16) { const f32x4 v = gld16f(rss_in, q); sq = (v[0] + v[1]) + (v[2] + v[3]); }
                        else { const f32x4 v = gld16f(rss_in, q), w = gld16f(rss_in, q + 4); sq = ((v[0] + v[1]) + (v[2] + v[3])) + ((w[0] + w[1]) + (w[2] + w[3])); }
                        sq += __shfl_xor(sq, 16); sq += __shfl_xor(sq, 32); }
                    rs = __builtin_amdgcn_rsqf(sq * inv_k + 1e-6f);
                }
                const f32x4 a00 = acc[ai][0][m][0] * rs, a01 = acc[ai][0][m][1] * rs, a10 = acc[ai][1][m][0] * rs, a11 = acc[ai][1][m][1] * rs;
                const int cw = wc * 32 + 8 * fq;
                switch (mode) {
                case EM_SWIGLU: {
                    f32x4 v0, v1;
#pragma unroll
                    for (int i = 0; i < 4; ++i) { v0[i] = a00[i] * fast_sigmoid(a00[i]) * a10[i]; v1[i] = a01[i] * fast_sigmoid(a01[i]) * a11[i]; }
                    u32x4 w; w.x = cvt_pk_bf16(v0[0], v0[1]); w.y = cvt_pk_bf16(v0[2], v0[3]); w.z = cvt_pk_bf16(v1[0], v1[1]); w.w = cvt_pk_bf16(v1[2], v1[3]);
                    gst16(ob, ob + (size_t)row * ldo + u.pn * 128 + cw, w);
                } break;
                case EM_RES: {
                    float ss = 0.f;
#pragma unroll
                    for (int bj = 0; bj < 2; ++bj) {
                        const size_t off = (size_t)row * 1024 + u.pn * 256 + bj * 128 + cw;
                        const f32x4 b0 = gld16f(base, base + off), b1 = gld16f(base, base + off + 4);
                        const f32x4 v0 = b0 + alpha * (bj ? a10 : a00), v1 = b1 + alpha * (bj ? a11 : a01);
                        gst16f(out, out + off, v0); gst16f(out, out + off + 4, v1);
                        u32x4 w; w.x = cvt_pk_bf16(v0[0], v0[1]); w.y = cvt_pk_bf16(v0[2], v0[3]); w.z = cvt_pk_bf16(v1[0], v1[1]); w.w = cvt_pk_bf16(v1[2], v1[3]);
                        gst16(ob, ob + off, w);
                        ss += (v0[0] * v0[0] + v0[1] * v0[1]) + (v0[2] * v0[2] + v0[3] * v0[3]) + (v1[0] * v1[0] + v1[1] * v1[1]) + (v1[2] * v1[2] + v1[3] * v1[3]);
                    }
                    ss += __shfl_xor(ss, 16); ss += __shfl_xor(ss, 32);
                    if (fq == 0) gst4f(rss_out, rss_out + (size_t)row * 16 + u.pn * 4 + wc, ss);
                } break;
                case EM_GLU: {
                    const size_t off = (size_t)row * 1024 + u.pn * 128 + cw;
                    const f32x4 b0 = gld16f(base, base + off), b1 = gld16f(base, base + off + 4);
                    f32x4 v0, v1;
#pragma unroll
                    for (int i = 0; i < 4; ++i) { v0[i] = b0[i] + a00[i] * fast_sigmoid(a10[i]); v1[i] = b1[i] + a01[i] * fast_sigmoid(a11[i]); }
                    gst16f(out, out + off, v0); gst16f(out, out + off + 4, v1);
                    u32x4 w; w.x = cvt_pk_bf16(v0[0], v0[1]); w.y = cvt_pk_bf16(v0[2], v0[3]); w.z = cvt_pk_bf16(v1[0], v1[1]); w.w = cvt_pk_bf16(v1[2], v1[3]);
                    gst16(ob, ob + off, w);
                    float ss = (v0[0] * v0[0] + v0[1] * v0[1]) + (v0[2] * v0[2] + v0[3] * v0[3]) + (v1[0] * v1[0] + v1[1] * v1[1]) + (v1[2] * v1[2] + v1[3] * v1[3]);
                    ss += __shfl_xor(ss, 16); ss += __shfl_xor(ss, 32);
                    if (fq == 0) gst4f(rss_out, rss_out + (size_t)row * 32 + u.pn * 4 + wc, ss);
                } break;
                case EM_DKV: {
                    if (wc < 2) {
                        u32x4 w0, w1;
                        w0.x = cvt_pk_bf16(a00[0], a00[1]); w0.y = cvt_pk_bf16(a00[2], a00[3]); w0.z = cvt_pk_bf16(a01[0], a01[1]); w0.w = cvt_pk_bf16(a01[2], a01[3]);
                        w1.x = cvt_pk_bf16(a10[0], a10[1]); w1.y = cvt_pk_bf16(a10[2], a10[3]); w1.z = cvt_pk_bf16(a11[0], a11[1]); w1.w = cvt_pk_bf16(a11[2], a11[3]);
                        gst16(ob, ob + (size_t)row * P256 + cw, w0); gst16(ob, ob + (size_t)row * P256 + 64 + cw, w1);
                        float ss = 0.f;
#pragma unroll
                        for (int i = 0; i < 4; ++i) ss += a00[i] * a00[i] + a01[i] * a01[i] + a10[i] * a10[i] + a11[i] * a11[i];
                        ss += __shfl_xor(ss, 16); ss += __shfl_xor(ss, 32);
                        if (fq == 0) gst4f(rss_out, rss_out + (size_t)row * 4 + wc, ss);
                    } else if (wc == 2) {
                        if (fq == 0) { gst4f(rss_out, rss_out + (size_t)row * 4 + 2, 0.f); gst4f(rss_out, rss_out + (size_t)row * 4 + 3, 0.f); }
                        const int j0 = 8 * fq;
                        const f32x4 c0 = gld16f(aux0, aux0 + (size_t)row * 32 + j0), c1 = gld16f(aux0, aux0 + (size_t)row * 32 + j0 + 4);
                        const f32x4 s0 = gld16f(aux1, aux1 + (size_t)row * 32 + j0), s1 = gld16f(aux1, aux1 + (size_t)row * 32 + j0 + 4);
                        const f32x4 o10 = a00 * c0 - a10 * s0, o11 = a01 * c1 - a11 * s1, o20 = a00 * s0 + a10 * c0, o21 = a01 * s1 + a11 * c1;
                        u32x4 w0, w1;
                        w0.x = cvt_pk_bf16(o10[0], o10[1]); w0.y = cvt_pk_bf16(o10[2], o10[3]); w0.z = cvt_pk_bf16(o11[0], o11[1]); w0.w = cvt_pk_bf16(o11[2], o11[3]);
                        w1.x = cvt_pk_bf16(o20[0], o20[1]); w1.y = cvt_pk_bf16(o20[2], o20[3]); w1.z = cvt_pk_bf16(o21[0], o21[1]); w1.w = cvt_pk_bf16(o21[2], o21[3]);
                        gst16(ob2, ob2 + (size_t)row * 64 + j0, w0); gst16(ob2, ob2 + (size_t)row * 64 + 32 + j0, w1);
                    }
                } break;
                case EM_UKV: {
                    u32x4 w0, w1;
                    w0.x = cvt_pk_bf16(a00[0], a00[1]); w0.y = cvt_pk_bf16(a00[2], a00[3]); w0.z = cvt_pk_bf16(a01[0], a01[1]); w0.w = cvt_pk_bf16(a01[2], a01[3]);
                    w1.x = cvt_pk_bf16(a10[0], a10[1]); w1.y = cvt_pk_bf16(a10[2], a10[3]); w1.z = cvt_pk_bf16(a11[0], a11[1]); w1.w = cvt_pk_bf16(a11[2], a11[3]);
                    gst16(ob, ob + (size_t)row * 1024 + u.pn * 128 + cw, w0); gst16(ob2, ob2 + (size_t)row * 1024 + u.pn * 128 + cw, w1);
                } break;
                case EM_DQ: {
                    u32x4 w0, w1;
                    w0.x = cvt_pk_bf16(a00[0], a00[1]); w0.y = cvt_pk_bf16(a00[2], a00[3]); w0.z = cvt_pk_bf16(a01[0], a01[1]); w0.w = cvt_pk_bf16(a01[2], a01[3]);
                    w1.x = cvt_pk_bf16(a10[0], a10[1]); w1.y = cvt_pk_bf16(a10[2], a10[3]); w1.z = cvt_pk_bf16(a11[0], a11[1]); w1.w = cvt_pk_bf16(a11[2], a11[3]);
                    gst16(ob, ob + (size_t)row * P256 + cw, w0); gst16(ob, ob + (size_t)row * P256 + 128 + cw, w1);
                    float ss = 0.f;
#pragma unroll
                    for (int i = 0; i < 4; ++i) ss += a00[i] * a00[i] + a01[i] * a01[i] + a10[i] * a10[i] + a11[i] * a11[i];
                    ss += __shfl_xor(ss, 16); ss += __shfl_xor(ss, 32);
                    if (fq == 0) gst4f(rss_out, rss_out + (size_t)row * 4 + wc, ss);
                } break;
                case EM_UQ: {
                    const float qs = alpha;
                    if (u.pn < 4) {
                        u32x4 w0, w1;
                        w0.x = cvt_pk_bf16(a00[0] * qs, a00[1] * qs); w0.y = cvt_pk_bf16(a00[2] * qs, a00[3] * qs); w0.z = cvt_pk_bf16(a01[0] * qs, a01[1] * qs); w0.w = cvt_pk_bf16(a01[2] * qs, a01[3] * qs);
                        w1.x = cvt_pk_bf16(a10[0] * qs, a10[1] * qs); w1.y = cvt_pk_bf16(a10[2] * qs, a10[3] * qs); w1.z = cvt_pk_bf16(a11[0] * qs, a11[1] * qs); w1.w = cvt_pk_bf16(a11[2] * qs, a11[3] * qs);
                        gst16(ob, ob + (size_t)row * 1536 + (2 * u.pn) * 192 + cw, w0); gst16(ob, ob + (size_t)row * 1536 + (2 * u.pn + 1) * 192 + cw, w1);
                    } else {
                        const int head = 4 * (u.pn - 4) + wc, j0 = 8 * fq;
                        const f32x4 c0 = gld16f(aux0, aux0 + (size_t)row * 32 + j0) * qs, c1 = gld16f(aux0, aux0 + (size_t)row * 32 + j0 + 4) * qs;
                        const f32x4 s0 = gld16f(aux1, aux1 + (size_t)row * 32 + j0) * qs, s1 = gld16f(aux1, aux1 + (size_t)row * 32 + j0 + 4) * qs;
                        const f32x4 o10 = a00 * c0 - a10 * s0, o11 = a01 * c1 - a11 * s1, o20 = a00 * s0 + a10 * c0, o21 = a01 * s1 + a11 * c1;
                        u32x4 w0, w1;
                        w0.x = cvt_pk_bf16(o10[0], o10[1]); w0.y = cvt_pk_bf16(o10[2], o10[3]); w0.z = cvt_pk_bf16(o11[0], o11[1]); w0.w = cvt_pk_bf16(o11[2], o11[3]);
                        w1.x = cvt_pk_bf16(o20[0], o20[1]); w1.y = cvt_pk_bf16(o20[2], o20[3]); w1.z = cvt_pk_bf16(o21[0], o21[1]); w1.w = cvt_pk_bf16(o21[2], o21[3]);
                        bf16_t* qp = ob + (size_t)row * 1536 + head * 192 + 128 + j0;
                        gst16(ob, qp, w0); gst16(ob, qp + 32, w1);
                    }
                } break;
                case EM_SEND: {
                    float* p = fout + (size_t)row * 128 + cw;
                    gst16f(fout, p, a00); gst16f(fout, p + 4, a01);
                } break;
                case EM_Y: {
                    const int g = row >> 10, n = row & 1023;
#pragma unroll
                    for (int bj = 0; bj < 2; ++bj) {
                        const int c = bj * 128 + cw, tt = c >> 4, o0 = c & 15;
                        const u32x4 uu = gld16(ua, ua + (size_t)row * 384 + c);
                        const f32x4 d0 = *(const f32x4*)(aux0 + g * 16 + o0), d1 = *(const f32x4*)(aux0 + g * 16 + o0 + 4);
                        const f32x4 y0 = bj ? a10 : a00, y1 = bj ? a11 : a01;
                        float v[8];
                        { const h16x8 uh = __builtin_bit_cast(h16x8, uu);
                          v[0] = y0[0] + d0[0] * (float)uh[0]; v[1] = y0[1] + d0[1] * (float)uh[1]; v[2] = y0[2] + d0[2] * (float)uh[2]; v[3] = y0[3] + d0[3] * (float)uh[3];
                          v[4] = y1[0] + d1[0] * (float)uh[4]; v[5] = y1[1] + d1[1] * (float)uh[5]; v[6] = y1[2] + d1[2] * (float)uh[6]; v[7] = y1[3] + d1[3] * (float)uh[7]; }
#pragma unroll
                        for (int i = 0; i < 8; ++i) v[i] = gelu_tanh_f(v[i]);
                        u32x4 w; w.x = cvt_pk_bf16(v[0], v[1]); w.y = cvt_pk_bf16(v[2], v[3]); w.z = cvt_pk_bf16(v[4], v[5]); w.w = cvt_pk_bf16(v[6], v[7]);
                        gst16(ob, ob + (size_t)(16 * n + tt) * 1024 + g * 16 + o0, w);
                    }
                } break;
                default: break;
                }
            }
    }
};

template <class Epi, class Sched, bool ALIGN_EPI = false, bool SP2 = false>
__device__ __forceinline__ void gemm_phase(PG8_LAS unsigned char* lds, const Gemm g, const Sched& S, const Epi& E, int tid_in) {
    const int tid = tid_in, wid = __builtin_amdgcn_readfirstlane(tid >> 6), lane = tid & 63, wr = wid >> 2, wc = wid & 3, fr = lane & 15, fq = lane >> 4;
    const int K = g.K, nt = K / BK;
    unsigned voffA[2], voffB[2];
#pragma unroll
    for (int i = 0; i < 2; ++i) { int R, C; stage_rc(tid * 16 + i * 8192, R, C); const int Rb = Epi::PERM ? ((R & ~31) + perm32(R & 31)) : R;
        voffA[i] = (unsigned)(R * g.lda + C) * 2u; voffB[i] = (unsigned)(Rb * g.ldb + C) * 2u; }
    const size_t kstep = (size_t)(BK * 2);
    const size_t hstepA = (size_t)HALF * g.lda * 2, hstepB = (size_t)HALF * g.ldb * 2;
    const size_t tstepA = 2 * hstepA, tstepB = 2 * hstepB;
    const unsigned ldsw = (unsigned)wid * 1024u;
    const int aoff = lds_byte(wr * 64 + fr, fq * 8), boff = lds_byte(wc * 32 + fr, fq * 8);
#define PG8_SA(b, h) (((b) * 2 + (h)) * HTB)
#define PG8_SB(b, h) ((4 + (b) * 2 + (h)) * HTB)
#define PG8_STAGE(bufoff, gbase, voff) do { _Pragma("unroll") for (int _i = 0; _i < 2; ++_i) \
        __builtin_amdgcn_global_load_lds((const unsigned*)((const char*)(gbase) + (voff)[_i]), (PG8_LAS unsigned*)(lds + (bufoff) + ldsw + _i * 8192), 16, 0, PG8_AUX); } while (0)
#define PG8_LDA(dst, b, h) do { _Pragma("unroll") for (int m = 0; m < 4; ++m) _Pragma("unroll") for (int k = 0; k < 2; ++k) dst[m][k] = *(const PG8_LAS bf16x8*)(lds + PG8_SA(b, h) + aoff + m * 2048 + k * 1024); } while (0)
#define PG8_LDB(dst, b, h) do { _Pragma("unroll") for (int n = 0; n < 2; ++n) _Pragma("unroll") for (int k = 0; k < 2; ++k) dst[n][k] = *(const PG8_LAS bf16x8*)(lds + PG8_SB(b, h) + boff + n * 2048 + k * 1024); } while (0)
#define PG8_MMA(ai, bj, At, Bt) do { __builtin_amdgcn_s_setprio(1); _Pragma("unroll") for (int m = 0; m < 4; ++m) _Pragma("unroll") for (int n = 0; n < 2; ++n) _Pragma("unroll") for (int k = 0; k < 2; ++k) \
        acc[ai][bj][m][n] = __builtin_amdgcn_mfma_f32_16x16x32_f16(__builtin_bit_cast(h16x8, Bt[n][k]), __builtin_bit_cast(h16x8, At[m][k]), acc[ai][bj][m][n], 0, 0, 0); __builtin_amdgcn_s_setprio(0); } while (0)
#define PG8_WAIT_V(n) asm volatile("s_waitcnt vmcnt(" #n ")" ::: "memory")
#define PG8_WAIT_L(n) asm volatile("s_waitcnt lgkmcnt(" #n ")" ::: "memory")
#define PG8_BAR __builtin_amdgcn_s_barrier()
#define PG8_SCHED __builtin_amdgcn_sched_barrier(0)
    Unit cur, nxt; int ui = 0;
    if (!S.next(0, cur)) return;
    f32x4 acc[2][2][4][2];
#pragma unroll
    for (int a = 0; a < 2; ++a)
#pragma unroll
        for (int b = 0; b < 2; ++b)
#pragma unroll
            for (int m = 0; m < 4; ++m)
#pragma unroll
                for (int n = 0; n < 2; ++n) acc[a][b][m][n] = (f32x4){0.f, 0.f, 0.f, 0.f};
    bf16x8 At[4][2], B0[2][2], B1[2][2];
    const char* cA = (const char*)g.A + (size_t)cur.pm * tstepA; const char* cB = (const char*)g.Bt + (size_t)(cur.pm / g.bgt) * g.bgbytes + (size_t)cur.pn * tstepB;
    S.a_ready(cur);
    if constexpr (SP2) {
        PG8_STAGE(PG8_SB(0, 0), cB, voffB); PG8_STAGE(PG8_SB(0, 1), cB + hstepB, voffB); PG8_STAGE(PG8_SA(0, 0), cA, voffA); PG8_STAGE(PG8_SA(0, 1), cA + hstepA, voffA);
        if (wr == 1) PG8_BAR;
        PG8_WAIT_V(2); PG8_BAR;
        PG8_STAGE(PG8_SB(1, 0), cB + kstep, voffB); PG8_STAGE(PG8_SA(1, 0), cA + kstep, voffA); PG8_STAGE(PG8_SB(1, 1), cB + hstepB + kstep, voffB);
        PG8_WAIT_V(6); PG8_BAR;
    } else {
        PG8_STAGE(PG8_SB(0, 0), cB, voffB); PG8_STAGE(PG8_SA(0, 0), cA, voffA); PG8_STAGE(PG8_SB(0, 1), cB + hstepB, voffB); PG8_STAGE(PG8_SA(0, 1), cA + hstepA, voffA);
        if (wr == 1) PG8_BAR;
        PG8_WAIT_V(4); PG8_BAR;
        PG8_STAGE(PG8_SB(1, 0), cB + kstep, voffB); PG8_STAGE(PG8_SA(1, 0), cA + kstep, voffA); PG8_STAGE(PG8_SB(1, 1), cB + hstepB + kstep, voffB);
        PG8_WAIT_V(6); PG8_BAR;
    }
    for (;;) {
        const bool has_next = S.next(ui + 1, nxt);
        const char* nA = has_next ? (const char*)g.A + (size_t)nxt.pm * tstepA : cA; const char* nB = has_next ? (const char*)g.Bt + (size_t)(nxt.pm / g.bgt) * g.bgbytes + (size_t)nxt.pn * tstepB : cB;
        for (int t = 0; t < nt; t += 2) {
            const bool last = (t == nt - 2);
            const char* a1 = cA + (size_t)(t + 1) * kstep;
            const char* a2 = last ? nA : cA + (size_t)(t + 2) * kstep; const char* b2 = last ? nB : cB + (size_t)(t + 2) * kstep;
            const char* a3 = a2 + kstep; const char* b3 = b2 + kstep;
            if (last && has_next) S.a_ready(nxt);
            if constexpr (SP2) {
            PG8_LDB(B0, 0, 0); PG8_LDB(B1, 0, 1); PG8_SCHED; PG8_LDA(At, 0, 0); PG8_STAGE(PG8_SA(1, 1), a1 + hstepA, voffA);
            PG8_WAIT_V(8); PG8_WAIT_L(0); PG8_BAR; PG8_MMA(0, 0, At, B0); PG8_MMA(0, 1, At, B1); PG8_BAR; PG8_SCHED;
            PG8_LDA(At, 0, 1); PG8_STAGE(PG8_SB(0, 0), b2, voffB); PG8_STAGE(PG8_SB(0, 1), b2 + hstepB, voffB); PG8_STAGE(PG8_SA(0, 0), a2, voffA);
            PG8_WAIT_V(8); PG8_WAIT_L(0); PG8_BAR; PG8_MMA(1, 0, At, B0); PG8_MMA(1, 1, At, B1); PG8_BAR; PG8_SCHED;
            PG8_LDB(B0, 1, 0); PG8_LDB(B1, 1, 1); PG8_SCHED; PG8_LDA(At, 1, 0); PG8_STAGE(PG8_SA(0, 1), a2 + hstepA, voffA);
            PG8_WAIT_V(8); PG8_WAIT_L(0); PG8_BAR; PG8_MMA(0, 0, At, B0); PG8_MMA(0, 1, At, B1); PG8_BAR; PG8_SCHED;
            PG8_LDA(At, 1, 1); PG8_STAGE(PG8_SB(1, 0), b3, voffB); PG8_STAGE(PG8_SB(1, 1), b3 + hstepB, voffB); PG8_STAGE(PG8_SA(1, 0), a3, voffA);
            PG8_WAIT_V(8); PG8_WAIT_L(0); PG8_BAR; PG8_MMA(1, 0, At, B0); PG8_MMA(1, 1, At, B1); PG8_BAR; PG8_SCHED;
            } else {
            PG8_LDB(B0, 0, 0); PG8_SCHED; PG8_LDA(At, 0, 0); PG8_STAGE(PG8_SA(1, 1), a1 + hstepA, voffA);
            PG8_WAIT_L(8); PG8_BAR; PG8_WAIT_L(0); PG8_MMA(0, 0, At, B0); PG8_BAR; PG8_SCHED;
            PG8_LDB(B1, 0, 1); PG8_STAGE(PG8_SB(0, 0), b2, voffB);
            PG8_BAR; PG8_WAIT_L(0); PG8_MMA(0, 1, At, B1); PG8_BAR;
            PG8_LDA(At, 0, 1); PG8_STAGE(PG8_SA(0, 0), a2, voffA);
            PG8_BAR; PG8_WAIT_L(0); PG8_MMA(1, 0, At, B0); PG8_BAR; PG8_SCHED;
            PG8_STAGE(PG8_SB(0, 1), b2 + hstepB, voffB);
            PG8_WAIT_V(6); PG8_BAR; PG8_MMA(1, 1, At, B1); PG8_BAR;
            PG8_LDB(B0, 1, 0); PG8_SCHED; PG8_LDA(At, 1, 0); PG8_STAGE(PG8_SA(0, 1), a2 + hstepA, voffA);
            PG8_WAIT_L(8); PG8_BAR; PG8_WAIT_L(0); PG8_MMA(0, 0, At, B0); PG8_BAR; PG8_SCHED;
            PG8_LDB(B1, 1, 1); PG8_STAGE(PG8_SB(1, 0), b3, voffB);
            PG8_BAR; PG8_WAIT_L(0); PG8_MMA(0, 1, At, B1); PG8_BAR;
            PG8_LDA(At, 1, 1); PG8_STAGE(PG8_SA(1, 0), a3, voffA);
            PG8_BAR; PG8_WAIT_L(0); PG8_MMA(1, 0, At, B0); PG8_BAR; PG8_SCHED;
            PG8_STAGE(PG8_SB(1, 1), b3 + hstepB, voffB);
            PG8_WAIT_V(6); PG8_BAR; PG8_MMA(1, 1, At, B1); PG8_BAR;
            }
        }
        if constexpr (ALIGN_EPI) { if (wr == 0) PG8_BAR; }
        if constexpr (!Epi::AFTER_DRAIN) { E(acc, cur, wr, wc, fr, fq); S.done(cur); }
        if (!has_next) break;
#pragma unroll
        for (int a = 0; a < 2; ++a)
#pragma unroll
            for (int b = 0; b < 2; ++b)
#pragma unroll
                for (int m = 0; m < 4; ++m)
#pragma unroll
                    for (int n = 0; n < 2; ++n) acc[a][b][m][n] = (f32x4){0.f, 0.f, 0.f, 0.f};
        cur = nxt; cA = nA; cB = nB; ++ui;
        if constexpr (ALIGN_EPI) { if (wr == 1) PG8_BAR; }
    }
    PG8_WAIT_V(0);
    if constexpr (!ALIGN_EPI) { if (wr == 0) PG8_BAR; }
    PG8_BAR;
    if constexpr (Epi::AFTER_DRAIN) { E.fused(acc, cur, wr, wc, fr, fq, lds, wid, lane); S.done(cur); }
#undef PG8_SA
#undef PG8_SB
#undef PG8_STAGE
#undef PG8_LDA
#undef PG8_LDB
#undef PG8_MMA
#undef PG8_WAIT_V
#undef PG8_WAIT_L
#undef PG8_BAR
#undef PG8_SCHED
}

}

namespace attn {
typedef unsigned short bf16_t;
using bf16x8 = __attribute__((ext_vector_type(8))) short;
using s16x4 = __attribute__((ext_vector_type(4))) short;
using f32x16 = __attribute__((ext_vector_type(16))) float;
using u32x4 = __attribute__((ext_vector_type(4))) unsigned;
constexpr int NW = 8, QBLK = 32, KVBLK = 64;
constexpr int SHM_V = KVBLK * 128 * 2, SHM_K = KVBLK * 192 * 2, SHM_ATTN = 2 * SHM_V + 2 * SHM_K + NW * 64 * 4;
constexpr float THR = 8.f;
#ifndef ATTN_SDEPTH
#define ATTN_SDEPTH 2
#endif
constexpr int SDEPTH = ATTN_SDEPTH;
#define KSWZ(row, colB) ((row) * 384 + ((colB) ^ ((((row) >> 1) & 7) << 4)))
#define SBAR() __builtin_amdgcn_sched_barrier(0)
__device__ __forceinline__ int crow(int r, int hi) { return (r & 3) + 8 * (r >> 2) + 4 * hi; }
__device__ __forceinline__ unsigned cvtpk(float lo, float hi) { return pk2(lo, hi); }

__device__ __forceinline__ void partialSM(f32x16& p0, f32x16& p1, float& m_reg, float& mn, float& alpha) {
  float pmax = p0[0];
#pragma unroll
  for (int r = 1; r < 16; ++r) pmax = fmaxf(pmax, p0[r]);
#pragma unroll
  for (int r = 0; r < 16; ++r) pmax = fmaxf(pmax, p1[r]);
  { auto rr = __builtin_amdgcn_permlane32_swap(__float_as_uint(pmax), __float_as_uint(pmax), false, false);
    pmax = fmaxf(__uint_as_float(rr[0]), __uint_as_float(rr[1])); }
  if (__builtin_expect(__all(pmax - m_reg <= THR), 1)) { mn = m_reg; alpha = 1.f; }
  else { mn = fmaxf(m_reg, pmax); alpha = __builtin_amdgcn_exp2f(m_reg - mn); m_reg = mn; }
#pragma unroll
  for (int r = 0; r < 16; ++r) p0[r] = p0[r] - mn;
#pragma unroll
  for (int r = 0; r < 16; ++r) p1[r] = p1[r] - mn;
#pragma unroll
  for (int r = 0; r < 16; ++r) p0[r] = __builtin_amdgcn_exp2f(p0[r]);
}
__device__ __forceinline__ void finishSM(f32x16& p0, f32x16& p1, float alpha, float& l_reg, bf16x8& pa0, bf16x8& pa1, bf16x8& pa2, bf16x8& pa3) {
#pragma unroll
  for (int r = 0; r < 16; ++r) p1[r] = __builtin_amdgcn_exp2f(p1[r]);
  float ps = 0;
#pragma unroll
  for (int r = 0; r < 16; ++r) ps += p0[r];
#pragma unroll
  for (int r = 0; r < 16; ++r) ps += p1[r];
  { auto rr = __builtin_amdgcn_permlane32_swap(__float_as_uint(ps), __float_as_uint(ps), false, false);
    ps = __uint_as_float(rr[0]) + __uint_as_float(rr[1]); }
  l_reg = l_reg * alpha + ps;
#define PK4(P, BASE, OUT) do { unsigned a0 = cvtpk(P[BASE + 0], P[BASE + 1]), a1 = cvtpk(P[BASE + 2], P[BASE + 3]);   \
    unsigned b0 = cvtpk(P[BASE + 4], P[BASE + 5]), b1 = cvtpk(P[BASE + 6], P[BASE + 7]);                              \
    auto r0 = __builtin_amdgcn_permlane32_swap(a0, b0, false, false); auto r1 = __builtin_amdgcn_permlane32_swap(a1, b1, false, false); \
    u32x4 w = {r0[0], r1[0], r0[1], r1[1]}; OUT = *reinterpret_cast<bf16x8*>(&w); } while (0)
  PK4(p0, 0, pa0); PK4(p0, 8, pa1); PK4(p1, 0, pa2); PK4(p1, 8, pa3);
#undef PK4
}
__device__ __forceinline__ void qkt(f32x16& p0, f32x16& p1, const char* Ks, const bf16x8* qr, int r32, int hi) {
  p0 = f32x16{}; p1 = f32x16{};
#pragma unroll
  for (int d0 = 0; d0 < 12; ++d0) { const int cb = (d0 * 16 + hi * 8) * 2;
    const bf16x8 b0 = *reinterpret_cast<const bf16x8*>(Ks + KSWZ(r32, cb));
    const bf16x8 b1 = *reinterpret_cast<const bf16x8*>(Ks + KSWZ(32 + r32, cb));
    p0 = __builtin_amdgcn_mfma_f32_32x32x16_f16(__builtin_bit_cast(h16x8, b0), __builtin_bit_cast(h16x8, qr[d0]), p0, 0, 0, 0);
    p1 = __builtin_amdgcn_mfma_f32_32x32x16_f16(__builtin_bit_cast(h16x8, b1), __builtin_bit_cast(h16x8, qr[d0]), p1, 0, 0, 0); }
}
__device__ __forceinline__ int v_st(int k, int c) { const int kk = (k & ~0xC) | ((k & 4) << 1) | ((k & 8) >> 1); return ((kk >> 3) * 4 + (c >> 5)) * 512 + ((kk & 7) * 32 + (c & 31)) * 2; }
__device__ __forceinline__ int v_rd_base(int lane) { return ((lane & 3) << 3) | (((lane >> 2) & 3) << 6) | (((lane >> 4) & 1) << 5) | (((lane >> 5) & 1) << 8); }
constexpr int v_rd_off(int d0, int ks, int half) { return d0 * 512 + ks * 4096 + half * 2048; }
template <int OFF> __device__ __forceinline__ s16x4 tr_read(int vb) {
  s16x4 r; asm volatile("ds_read_b64_tr_b16 %0, %1 offset:%2" : "=&v"(r) : "v"(vb), "i"(OFF) : "memory"); return r;
}
template <int D0> __device__ __forceinline__ void pv_one(f32x16& od, int vb, bf16x8 pa0, bf16x8 pa1, bf16x8 pa2, bf16x8 pa3) {
  const s16x4 l0 = tr_read<v_rd_off(D0, 0, 0)>(vb), h0 = tr_read<v_rd_off(D0, 0, 1)>(vb), l1 = tr_read<v_rd_off(D0, 1, 0)>(vb), h1 = tr_read<v_rd_off(D0, 1, 1)>(vb);
  const s16x4 l2 = tr_read<v_rd_off(D0, 2, 0)>(vb), h2 = tr_read<v_rd_off(D0, 2, 1)>(vb), l3 = tr_read<v_rd_off(D0, 3, 0)>(vb), h3 = tr_read<v_rd_off(D0, 3, 1)>(vb);
  asm volatile("s_waitcnt lgkmcnt(0)" ::: "memory"); SBAR();
#define PK(L, H) (bf16x8){L[0], L[1], L[2], L[3], H[0], H[1], H[2], H[3]}
  od = __builtin_amdgcn_mfma_f32_32x32x16_f16(__builtin_bit_cast(h16x8, pa0), __builtin_bit_cast(h16x8, PK(l0, h0)), od, 0, 0, 0);
  od = __builtin_amdgcn_mfma_f32_32x32x16_f16(__builtin_bit_cast(h16x8, pa1), __builtin_bit_cast(h16x8, PK(l1, h1)), od, 0, 0, 0);
  od = __builtin_amdgcn_mfma_f32_32x32x16_f16(__builtin_bit_cast(h16x8, pa2), __builtin_bit_cast(h16x8, PK(l2, h2)), od, 0, 0, 0);
  od = __builtin_amdgcn_mfma_f32_32x32x16_f16(__builtin_bit_cast(h16x8, pa3), __builtin_bit_cast(h16x8, PK(l3, h3)), od, 0, 0, 0);
#undef PK
}
__device__ __forceinline__ void pv_d0(f32x16* o, int vb, bf16x8 pa0, bf16x8 pa1, bf16x8 pa2, bf16x8 pa3) {
  pv_one<0>(o[0], vb, pa0, pa1, pa2, pa3); pv_one<1>(o[1], vb, pa0, pa1, pa2, pa3); pv_one<2>(o[2], vb, pa0, pa1, pa2, pa3); pv_one<3>(o[3], vb, pa0, pa1, pa2, pa3);
}

__device__ __forceinline__ void attn_unit(const bf16_t* __restrict__ Qu, const bf16_t* __restrict__ Knh, const bf16_t* __restrict__ Krb, const bf16_t* __restrict__ Vh,
                                          bf16_t* __restrict__ Ou, int NT, int qb4, char* lds, int tid_in) {
  const int tid = tid_in, wid = __builtin_amdgcn_readfirstlane(tid >> 6), lane = tid & 63, r32 = lane & 31, hi = lane >> 5;
  const int lim = qb4 + (wid >> 1);
  char* V_lds = lds; char* K_lds = lds + 2 * SHM_V;
  float* ws = (float*)(lds + 2 * SHM_V + 2 * SHM_K) + wid * 64; float* li_l = ws; float* al_l = ws + 32;
  float m_reg = -1e30f, l_reg = 0; f32x16 o[4] = {}; bf16x8 qr[12];
  const bf16_t* Qw = Qu + (long)(wid * QBLK + r32) * 1536 + hi * 8;
#pragma unroll
  for (int d0 = 0; d0 < 12; ++d0) qr[d0] = __builtin_bit_cast(bf16x8, gld16(Qu, Qw + d0 * 16));
  const int kr0 = tid >> 4, kch = tid & 15, rr0 = tid >> 3, rch = tid & 7, vsc = (tid & 15) * 8;
  const int kst0 = KSWZ(kr0, kch * 16), kst1 = KSWZ(32 + kr0, kch * 16), kst2 = KSWZ(rr0, 256 + rch * 16), vst0 = v_st(kr0, vsc), vst1 = v_st(32 + kr0, vsc);
  const int vb0 = (int)(uintptr_t)V_lds + v_rd_base(lane);
  bf16x8 sk0, sk1, sk2, sv0, sv1;
#define LD8B(base, p) (__builtin_bit_cast(bf16x8, gld16((base), (p))))
#define SLOAD(key0) do { sv0 = LD8B(Vh, Vh + (long)((key0) + kr0) * 1024 + vsc); sv1 = LD8B(Vh, Vh + (long)((key0) + 32 + kr0) * 1024 + vsc); \
    sk0 = LD8B(Knh, Knh + (long)((key0) + kr0) * 1024 + kch * 8); sk1 = LD8B(Knh, Knh + (long)((key0) + 32 + kr0) * 1024 + kch * 8); \
    sk2 = LD8B(Krb, Krb + (long)((key0) + rr0) * 64 + rch * 8); } while (0)
#define SWRITE(b) do { *(bf16x8*)(V_lds + (b) * SHM_V + vst0) = sv0; *(bf16x8*)(V_lds + (b) * SHM_V + vst1) = sv1; \
    *(bf16x8*)(K_lds + (b) * SHM_K + kst0) = sk0; *(bf16x8*)(K_lds + (b) * SHM_K + kst1) = sk1; *(bf16x8*)(K_lds + (b) * SHM_K + kst2) = sk2; } while (0)
  SLOAD(0); asm volatile("s_waitcnt vmcnt(0)" ::: "memory"); SWRITE(0); __syncthreads();
  for (int j = 0; j < NT; ++j) {
    const int buf = j & 1;
    if (j + 1 < NT) SLOAD((j + 1) * KVBLK);
    if (j <= lim) {
      f32x16 p0, p1; float mn, alpha; bf16x8 pa0, pa1, pa2, pa3;
      qkt(p0, p1, K_lds + buf * SHM_K, qr, r32, hi);
      partialSM(p0, p1, m_reg, mn, alpha);
      finishSM(p0, p1, alpha, l_reg, pa0, pa1, pa2, pa3);
      if (__any(alpha < 1.f)) { if (hi == 0) al_l[r32] = alpha; asm volatile("s_waitcnt lgkmcnt(0)" ::: "memory");
#pragma unroll
        for (int d = 0; d < 4; ++d)
#pragma unroll
          for (int r = 0; r < 16; ++r) o[d][r] *= al_l[crow(r, hi)]; }
      SBAR();
      pv_d0(o, vb0 + buf * (int)SHM_V, pa0, pa1, pa2, pa3);
    }
    if (j + 1 < NT) { asm volatile("s_waitcnt vmcnt(0)" ::: "memory"); SWRITE(buf ^ 1); }
    __syncthreads();
  }
  if (hi == 0) li_l[r32] = l_reg; asm volatile("s_waitcnt lgkmcnt(0)" ::: "memory");
  float rli[16];
#pragma unroll
  for (int r = 0; r < 16; ++r) rli[r] = __builtin_amdgcn_rcpf(li_l[crow(r, hi)]);
  bf16_t* Ow = Ou + (long)(wid * QBLK) * 1024;
#pragma unroll
  for (int r = 0; r < 16; ++r) { const int orow = crow(r, hi);
#pragma unroll
    for (int d0 = 0; d0 < 4; ++d0) gst2(Ou, Ow + (long)orow * 1024 + d0 * 32 + r32, (bf16_t)(cvtpk(o[d0][r] * rli[r], 0.f) & 0xffffu)); }
  __syncthreads();
#undef LD8B
#undef SLOAD
#undef SWRITE
}
__device__ __forceinline__ void attn_phase(char* lds, const bf16_t* Q, const bf16_t* Kn, const bf16_t* Kr, const bf16_t* V, bf16_t* O, int vcu, int G, int tid_in) {
  for (int v = vcu; v < 256; v += G) {
    const int bh = v >> 2, b = bh >> 3, h = bh & 7, s = v & 3;
#pragma unroll 1
    for (int i = 0; i < 2; ++i) {
      const int qb = i ? 7 - s : s;
      const long row0 = (long)b * 2048 + qb * 256;
      attn_unit(Q + row0 * 1536 + h * 192, Kn + (long)b * 2048 * 1024 + h * 128, Kr + (long)b * 2048 * 64, V + (long)b * 2048 * 1024 + h * 128, O + row0 * 1024 + h * 128, 4 * qb + 4, 4 * qb, lds, tid_in);
    }
  }
}
#undef KSWZ
#undef SBAR
}


#define XB_TMO      128
#define XB_XCNT(j)  (256  + 64 * (j))
#define XB_XSUB(j)  (1280 + 64 * (j))
#define XB_XGEN(j)  (2304 + 64 * (j))
#define XB_TOP      3328
#define XB_TOPGEN   3392
#define XCD_BAR_WORDS 3456
#define XB_SPIN_CAP (1u << 18)

__device__ __forceinline__ unsigned xb_ld(unsigned* p)              { return __hip_atomic_load(p, __ATOMIC_RELAXED, __HIP_MEMORY_SCOPE_AGENT); }
__device__ __forceinline__ unsigned xb_add(unsigned* p, unsigned v) { return __hip_atomic_fetch_add(p, v, __ATOMIC_RELAXED, __HIP_MEMORY_SCOPE_AGENT); }
__device__ __forceinline__ unsigned xb_xcc_id() { return (unsigned)__builtin_amdgcn_s_getreg((3 << 11) | 20) & 0xFu; }
#define XB_SPIN(cond, bar) do { unsigned _sp = 0; while (cond) { __builtin_amdgcn_s_sleep(1); \
    if ((++_sp & 255u) == 0u) { if (xb_ld(&(bar)[XB_TMO])) break; if (_sp > XB_SPIN_CAP) { atomicAdd(&(bar)[XB_TMO], 1u); break; } } } } while (0)

struct XcdBarrier {
    unsigned* bar; unsigned x;
    volatile LAS unsigned* st;
};

__device__ __forceinline__ XcdBarrier xcd_barrier_post(unsigned* bar, volatile LAS unsigned* st) {
    XcdBarrier b; b.bar = bar; b.x = xb_xcc_id(); b.st = st;
    if (threadIdx.x == 0) (void)xb_add(&bar[XB_XCNT(b.x)], 1u);
    return b;
}
__device__ __forceinline__ void xcd_barrier_complete(unsigned* bar, unsigned x, unsigned& nloc, unsigned& nx) {
    const unsigned G = gridDim.x * gridDim.y * gridDim.z;
    unsigned sum, cnt, mine, sp = 0u;
    for (;;) {
        sum = 0u; cnt = 0u; mine = 0u;
#pragma unroll
        for (unsigned j = 0; j < 16; ++j) { const unsigned c = xb_ld(&bar[XB_XCNT(j)]); sum += c; cnt += (c > 0u) ? 1u : 0u; mine = (j == x) ? c : mine; }
        if (sum == G) break;
        __builtin_amdgcn_s_sleep(1);
        if ((++sp & 255u) == 0u) { if (xb_ld(&bar[XB_TMO])) break; if (sp > XB_SPIN_CAP) { atomicAdd(&bar[XB_TMO], 1u); break; } }
    }
    nloc = mine > 0u ? mine : 1u; nx = cnt > 0u ? cnt : 1u;
}

__device__ __forceinline__ void xcd_barrier(const XcdBarrier& b) {
    asm volatile("s_waitcnt vmcnt(0)" ::: "memory");
    __syncthreads();
    if (threadIdx.x == 0) {
        unsigned* bar = b.bar;
        __builtin_amdgcn_s_waitcnt(0);
        unsigned nloc = b.st[0], nx = b.st[1];
        if (nloc == 0u) { xcd_barrier_complete(bar, b.x, nloc, nx); b.st[0] = nloc; b.st[1] = nx; }
        const unsigned old = xb_add(&bar[XB_XSUB(b.x)], 1u);
        const unsigned gen = old / nloc;
        if (old + 1u == (gen + 1u) * nloc) {
            __builtin_amdgcn_fence(__ATOMIC_RELEASE, "agent");
            asm volatile("s_waitcnt vmcnt(0)" ::: "memory");
            const unsigned og = xb_add(&bar[XB_TOP], 1u);
            const unsigned tg = og / nx;
            if (og + 1u == (tg + 1u) * nx) xb_add(&bar[XB_TOPGEN], 1u);
            else XB_SPIN(xb_ld(&bar[XB_TOPGEN]) == tg, bar);
            __builtin_amdgcn_fence(__ATOMIC_ACQUIRE, "agent");
            xb_add(&bar[XB_XGEN(b.x)], 1u);
            asm volatile("s_waitcnt vmcnt(0)" ::: "memory");
        } else {
            XB_SPIN(xb_ld(&bar[XB_XGEN(b.x)]) == gen, bar);
            __builtin_amdgcn_fence(__ATOMIC_ACQUIRE, "agent");
            asm volatile("s_waitcnt vmcnt(0)" ::: "memory");
        }
    }
    __syncthreads();
}


__device__ __forceinline__ void sb_begin(unsigned* ctlw) {
    if (threadIdx.x == 0) {
        unsigned e1 = 0xAAAAAAAAu, e2 = 0xAAAAAAAAu;
        __hip_atomic_compare_exchange_strong(ctlw + CW_BAR + 64, &e1, 0u, __ATOMIC_RELAXED, __ATOMIC_RELAXED, __HIP_MEMORY_SCOPE_AGENT);
        __hip_atomic_compare_exchange_strong(ctlw + CW_BAR + 128, &e2, 0u, __ATOMIC_RELAXED, __ATOMIC_RELAXED, __HIP_MEMORY_SCOPE_AGENT);
    }
}
__device__ __forceinline__ void sb_end(unsigned* ctlw) {
    if (threadIdx.x == 0) {
        const unsigned G = gridDim.x * gridDim.y * gridDim.z;
        if (__hip_atomic_fetch_add(ctlw + CW_BAR + 128, 1u, __ATOMIC_RELAXED, __HIP_MEMORY_SCOPE_AGENT) == G - 1u) {
            __hip_atomic_store(ctlw + CW_BAR + 64, 0u, __ATOMIC_RELAXED, __HIP_MEMORY_SCOPE_AGENT);
            __hip_atomic_store(ctlw + CW_BAR + 128, 0u, __ATOMIC_RELAXED, __HIP_MEMORY_SCOPE_AGENT);
        }
    }
}
__device__ __forceinline__ void simple_barrier(unsigned* ctlw, volatile LAS unsigned* misc) {
    unsigned* cnt = ctlw + CW_BAR + 64;
    asm volatile("s_waitcnt vmcnt(0)" ::: "memory");
#ifdef MK_DIAG
    { const int w = __builtin_amdgcn_readfirstlane(threadIdx.x >> 6);
      if ((threadIdx.x & 63) == 0) misc[16 + w] = misc[16 + w] + 1u; }
#endif
    __syncthreads();
    if (threadIdx.x == 0) {
        const unsigned e = misc[10] + 1u; misc[10] = e;
#ifdef MK_DIAG
        { unsigned bad = 0; for (int w = 0; w < 8; ++w) bad |= (misc[16 + w] != e); if (bad) atomicMax(ctlw + CW_CODE, 3u); }
        __hip_atomic_store(ctlw + 8192 + 64 * blockIdx.x, e, __ATOMIC_RELAXED, __HIP_MEMORY_SCOPE_WORKGROUP);
        asm volatile("s_waitcnt vmcnt(0)" ::: "memory");
#endif
#ifdef MK_SYS_FENCE
        __builtin_amdgcn_fence(__ATOMIC_RELEASE, "");
#else
        __builtin_amdgcn_fence(__ATOMIC_RELEASE, "agent");
#endif
        asm volatile("s_waitcnt vmcnt(0)" ::: "memory");
#ifdef DG_DELAY
        { const unsigned long long td = __builtin_amdgcn_s_memrealtime(); while (__builtin_amdgcn_s_memrealtime() - td < 5000ull) __builtin_amdgcn_s_sleep(8); }
#endif
        const unsigned want = e * (gridDim.x * gridDim.y * gridDim.z);
        __hip_atomic_fetch_add(cnt, 1u, __ATOMIC_RELAXED, __HIP_MEMORY_SCOPE_AGENT);
        const unsigned long long t0 = __builtin_amdgcn_s_memrealtime();
        while (__hip_atomic_load(cnt, __ATOMIC_RELAXED, __HIP_MEMORY_SCOPE_AGENT) < want) {
            __builtin_amdgcn_s_sleep(2);
            if (__builtin_amdgcn_s_memrealtime() - t0 > 5000000ull) { atomicMax(ctlw + CW_CODE, 1u); break; }
        }
#ifdef MK_SYS_FENCE
        __builtin_amdgcn_fence(__ATOMIC_ACQUIRE, "");
#else
        __builtin_amdgcn_fence(__ATOMIC_ACQUIRE, "agent");
#endif
        asm volatile("s_waitcnt vmcnt(0)" ::: "memory");
    }
    __syncthreads();
#ifdef MK_DIAG
    { const unsigned e = misc[10];
      const unsigned other = (blockIdx.x * 37u + threadIdx.x) % (gridDim.x);
      const unsigned v = *(const volatile unsigned*)(ctlw + 8192 + 64 * other);
      if (v != e) atomicMax(ctlw + CW_CODE, 2u); }
#endif
}
#ifdef MK_SIMPLE_BAR
#define GRID_BARRIER() simple_barrier((unsigned*)F.ctl, F.MISC)
#else
#define GRID_BARRIER() xcd_barrier(bar)
#endif

struct Args { const float* in[23]; float* out; unsigned char* ws; int ph_lo, ph_hi, li, pad; };
struct Frame {
    LAS unsigned char* lds;
    volatile LAS unsigned* MISC;
    gu32* ctl;
    int tid, lane, wave, vcu, G;
};

struct GemmParams { const bf16* A; const bf16* Bt; size_t bgbytes; int lda, ldb, K, bgt, gM, gN, crot, is_gemm, gsz, cskip; };
static_assert(sizeof(pg8::EpiParams) <= 128 && sizeof(GemmParams) <= 72 && PT_OFF + 24 * 8 <= LDS_BYTES, "LDS parameter blocks");
__device__ __forceinline__ unsigned long long rfl64(unsigned long long v) {
    const unsigned lo = __builtin_amdgcn_readfirstlane((unsigned)v), hi = __builtin_amdgcn_readfirstlane((unsigned)(v >> 32)); return ((unsigned long long)hi << 32) | lo; }
__device__ __forceinline__ void conv_item(const float* W, int ldw, int Ksrc, int srccol, const float* gain, bf16* WT, int ldk, int dstrow0, int k0, LAS float* scr, int lane) {
    const bool zero = (srccol < 0) || (k0 >= Ksrc);
    const int r8 = lane >> 3, c4 = (lane & 7) * 4;
    f32x4 v[8];
    if (!zero) {
#pragma unroll
        for (int i = 0; i < 8; ++i) v[i] = *(const GAS f32x4*)(unsigned long long)(W + (size_t)(k0 + 8 * i + r8) * ldw + srccol + c4);
        if (gain) {
#pragma unroll
            for (int i = 0; i < 8; ++i) v[i] = v[i] * gain[k0 + 8 * i + r8];
        }
    } else {
#pragma unroll
        for (int i = 0; i < 8; ++i) v[i] = (f32x4){0.f, 0.f, 0.f, 0.f};
    }
#pragma unroll
    for (int i = 0; i < 8; ++i) { LAS float* d = scr + (8 * i + r8) * 33 + c4; d[0] = v[i][0]; d[1] = v[i][1]; d[2] = v[i][2]; d[3] = v[i][3]; }
    LDS_WAIT(); asm volatile("" ::: "memory");
    const int c = lane & 7;
#pragma unroll
    for (int j = 0; j < 4; ++j) { const int n = (lane >> 3) + 8 * j; const LAS float* sp = scr + (8 * c) * 33 + n;
        v4u o; o.x = pk2(sp[0 * 33], sp[1 * 33]); o.y = pk2(sp[2 * 33], sp[3 * 33]); o.z = pk2(sp[4 * 33], sp[5 * 33]); o.w = pk2(sp[6 * 33], sp[7 * 33]);
        gst16(WT, WT + (size_t)(dstrow0 + n) * ldk + k0 + 8 * c, o); }
    LDS_WAIT(); asm volatile("" ::: "memory");
}
__device__ __forceinline__ int map_pair(int n0, int half_off) { const int pn = n0 >> 8, t = n0 & 255; return (t >> 7) * half_off + 128 * pn + (t & 127); }
__device__ __forceinline__ int map_dkv(int t) { if (t < 64) return t; if (t < 96) return 128 + (t - 64); if (t < 128) return -1; if (t < 192) return 64 + (t - 128); if (t < 224) return 160 + (t - 192); return -1; }
__device__ __forceinline__ int map_uq(int n0) {
    if (n0 < 1024) { const int pn = n0 >> 8, t = n0 & 255; return (2 * pn + (t >> 7)) * 192 + (t & 127); }
    const int r = n0 - 1024, q = r >> 8, t = r & 255, bj = t >> 7, hh = (t & 127) >> 5; return (4 * q + hh) * 192 + 128 + 32 * bj + (t & 31);
}
struct ConvJob { const float* W; int ldw, Ksrc, Kdst, Ndst, map; const float* gain; bf16* WT; int ldk; };
__device__ __forceinline__ void conv_job_item(const ConvJob& j, int item, LAS float* scr, int lane) {
    const int nblk = j.Ndst / 32, kb = item / nblk, nb = item % nblk, k0 = 64 * kb, n0 = 32 * nb;
    int sc;
    switch (j.map) { case 1: sc = map_pair(n0, FF); break; case 2: sc = map_pair(n0, 1024); break; case 3: sc = map_dkv(n0); break; case 4: sc = map_uq(n0); break; default: sc = n0; }
    conv_item(j.W, j.ldw, j.Ksrc, sc, j.gain, j.WT, j.ldk, n0, k0, scr, lane);
}

__device__ __forceinline__ void xconv_rows(Frame& F, const float* x, bf16* xb, float* rss) {
    const int gw = F.vcu * NWAVES + F.wave, NGW = F.G * NWAVES;
    for (int m = gw; m < M; m += NGW) {
        const GAS f32x4* xr = (const GAS f32x4*)(x + (size_t)m * D) + F.lane;
        f32x4 v[4]; float s = 0.f;
#pragma unroll
        for (int j = 0; j < 4; ++j) { v[j] = xr[64 * j]; s += (v[j].x * v[j].x + v[j].y * v[j].y) + (v[j].z * v[j].z + v[j].w * v[j].w); }
        s = wave_sum(s);
        if (F.lane == 0) gst4f(rss, rss + m, s);
        v2u* o8 = (v2u*)(xb + (size_t)m * D) + F.lane;
#pragma unroll
        for (int j = 0; j < 4; ++j) { v2u w; w.x = pk2(v[j].x, v[j].y); w.y = pk2(v[j].z, v[j].w);
            gst8(xb, o8 + 64 * j, w);
        }
    }
}
__device__ __forceinline__ void rss_rows(Frame& F, const float* x, float* rss) {
    const int gw = F.vcu * NWAVES + F.wave, NGW = F.G * NWAVES;
    for (int m = gw; m < M; m += NGW) {
        const GAS f32x4* xr = (const GAS f32x4*)(x + (size_t)m * D) + F.lane;
        float s = 0.f;
#pragma unroll
        for (int j = 0; j < 4; ++j) { const f32x4 v = xr[64 * j]; s += (v.x * v.x + v.y * v.y) + (v.z * v.z + v.w * v.w); }
        s = wave_sum(s);
        if (F.lane == 0) rss[m] = s;
    }
}
__device__ __forceinline__ void uconv_rows(Frame& F, const float* x, const float* rss, int nslot, const float* gain, bf16* ug) {
    const int gw = F.vcu * NWAVES + F.wave, NGW = F.G * NWAVES;
    f32x4 gv[4];
#pragma unroll
    for (int j = 0; j < 4; ++j) gv[j] = *(const f32x4*)(gain + F.lane * 16 + 4 * j);
    for (int m = gw; m < M; m += NGW) {
        const float r = __builtin_amdgcn_rsqf(wave_sum(F.lane < nslot ? gld4f(rss, rss + (size_t)m * nslot + F.lane) : 0.f) * (1.f / 1024.f) + EPS);
        const f32x4* xr = (const f32x4*)(x + (size_t)m * D + F.lane * 16);
        f32x4 v[4];
#pragma unroll
        for (int j = 0; j < 4; ++j) v[j] = gld16f(x, xr + j) * gv[j] * r;
        v4u w0, w1;
        w0.x = pk2(v[0].x, v[0].y); w0.y = pk2(v[0].z, v[0].w); w0.z = pk2(v[1].x, v[1].y); w0.w = pk2(v[1].z, v[1].w);
        w1.x = pk2(v[2].x, v[2].y); w1.y = pk2(v[2].z, v[2].w); w1.z = pk2(v[3].x, v[3].y); w1.w = pk2(v[3].z, v[3].w);
        bf16* dst = ug + ((size_t)F.lane * 1024 + (m >> 4)) * 384 + (m & 15) * 16;
        gst16(ug, dst, w0); gst16(ug, dst + 8, w1);
    }
}
__device__ __forceinline__ void s5_tables(Frame& F, int g, const float* lam_re, const float* lam_im, const float* log_step, const float* b_re, const float* b_im,
                                          const float* c_re, const float* c_im, bf16* TH, bf16* GT, float* L16) {
    LAS float* L = (LAS float*)(F.lds + RING_OFF);
    LAS float* pwr = L;
    LAS float* pwi = L + 17 * 64;
    LAS float* bbr = L + 34 * 64;
    LAS float* bbi = bbr + 1024;
    LAS float* ccr = bbi + 1024;
    LAS float* cci = ccr + 1024;
    LAS float* Kt = cci + 1024;
    const int tid = F.tid;
    if (tid < 64) {
        const int p = tid;
        const float step = expf(log_step[g]);
        const float lr = lam_re[g * 64 + p], li = lam_im[g * 64 + p];
        const double ang1 = (double)li * (double)step;
        for (int tau = 0; tau <= 16; ++tau) {
            double a = ang1 * (double)tau; a -= 6.283185307179586476925 * __builtin_rint(a * 0.15915494309189533577);
            const float mag = expf(lr * step * (float)tau), af = (float)a;
            pwr[tau * 64 + p] = mag * cosf(af); pwi[tau * 64 + p] = mag * sinf(af);
        }
        const float lbr = pwr[64 + p], lbi = pwi[64 + p];
        const float nr = lbr - 1.f, ni = lbi, den = lr * lr + li * li;
        const float cr = (nr * lr + ni * li) / den, ci = (ni * lr - nr * li) / den;
        for (int i = 0; i < 16; ++i) { const float br = b_re[((size_t)g * 64 + p) * 16 + i], bi = b_im[((size_t)g * 64 + p) * 16 + i];
            bbr[p * 16 + i] = cr * br - ci * bi; bbi[p * 16 + i] = cr * bi + ci * br; }
        gst4f(L16, L16 + (g * 64 + p) * 2, pwr[16 * 64 + p]); gst4f(L16, L16 + (g * 64 + p) * 2 + 1, pwi[16 * 64 + p]);
    }
    for (int i = tid; i < 1024; i += 512) { ccr[i] = c_re[(size_t)g * 1024 + i]; cci[i] = c_im[(size_t)g * 1024 + i]; }
    __syncthreads();
    for (int e = tid; e < 4096; e += 512) {
        const int tau = e >> 8, o = (e >> 4) & 15, i = e & 15; float acc = 0.f;
        for (int p = 0; p < 64; ++p) {
            const float cr = ccr[o * 64 + p], ci = cci[o * 64 + p], wr_ = pwr[tau * 64 + p], wi_ = pwi[tau * 64 + p];
            const float zr = cr * wr_ - ci * wi_, zi = cr * wi_ + ci * wr_;
            acc += zr * bbr[p * 16 + i] - zi * bbi[p * 16 + i];
        }
        Kt[e] = acc;
    }
    __syncthreads();
    bf16* THg = TH + (size_t)g * 256 * 384;
    for (int q = tid; q < 256 * 48; q += 512) {
        const int rowi = q / 48, ch = q % 48, t = rowi >> 4, o = rowi & 15; float v[8];
        if (ch < 32) { const int s = ch >> 1, ih = ch & 1;
#pragma unroll
            for (int e = 0; e < 8; ++e) v[e] = (s <= t) ? Kt[((t - s) * 16 + o) * 16 + ih * 8 + e] : 0.f;
        } else { const int k = (ch - 32) * 8;
#pragma unroll
            for (int e = 0; e < 8; ++e) { const int kk = k + e, p = kk & 63;
                const float cr = ccr[o * 64 + p], ci = cci[o * 64 + p], wr_ = pwr[(t + 1) * 64 + p], wi_ = pwi[(t + 1) * 64 + p];
                v[e] = (kk < 64) ? (cr * wr_ - ci * wi_) : -(cr * wi_ + ci * wr_); }
        }
        v4u w; w.x = pk2(v[0], v[1]); w.y = pk2(v[2], v[3]); w.z = pk2(v[4], v[5]); w.w = pk2(v[6], v[7]);
        gst16(TH, THg + (size_t)rowi * 384 + ch * 8, w);
    }
    bf16* GTg = GT + (size_t)g * 256 * 256;
    for (int q = tid; q < 256 * 32; q += 512) {
        const int rc = q >> 5, ch = q & 31, s = ch >> 1, ih = ch & 1, p = rc & 63; float v[8];
#pragma unroll
        for (int e = 0; e < 8; ++e) {
            if (rc < 128) { const float wr_ = pwr[(15 - s) * 64 + p], wi_ = pwi[(15 - s) * 64 + p], br = bbr[p * 16 + ih * 8 + e], bi = bbi[p * 16 + ih * 8 + e];
                v[e] = (rc < 64) ? (wr_ * br - wi_ * bi) : (wr_ * bi + wi_ * br); }
            else v[e] = 0.f;
        }
        v4u w; w.x = pk2(v[0], v[1]); w.y = pk2(v[2], v[3]); w.z = pk2(v[4], v[5]); w.w = pk2(v[6], v[7]);
        gst16(GT, GTg + (size_t)rc * 256 + ch * 8, w);
    }
    __syncthreads();
}
__device__ __forceinline__ void carry_scan(Frame& F, const float* Send, const float* L16, bf16* ug) {
    const int id = F.wave * F.G + F.vcu;
    if (id >= BATCH * NG) return;
    const int b = id / NG, g = id % NG, p = F.lane;
    const float lr = gld4f(L16, L16 + (g * 64 + p) * 2), li = gld4f(L16, L16 + (g * 64 + p) * 2 + 1);
    float xr = 0.f, xi = 0.f;
    const size_t row0 = (size_t)g * 1024 + b * 128;
    for (int c0 = 0; c0 < 128; c0 += 8) {
        float sr[8], si[8];
#pragma unroll
        for (int k = 0; k < 8; ++k) { sr[k] = gld4f(Send, Send + (row0 + c0 + k) * 128 + p); si[k] = gld4f(Send, Send + (row0 + c0 + k) * 128 + 64 + p); }
#pragma unroll
        for (int k = 0; k < 8; ++k) {
            bf16* dst = ug + (row0 + c0 + k) * 384 + 256;
            gst2(ug, dst + p, (bf16)f2bf(xr)); gst2(ug, dst + 64 + p, (bf16)f2bf(xi));
            const float nr = lr * xr - li * xi + sr[k], ni = lr * xi + li * xr + si[k];
            xr = nr; xi = ni;
        }
    }
}
__device__ __forceinline__ void rope_tables(Frame& F, const int* pos, float* ctab, float* stab) {
    const int gt = F.vcu * (NWAVES * 64) + F.tid, NT = F.G * NWAVES * 64;
    for (int e4 = gt; e4 < M * 8; e4 += NT) {
        const int m = e4 >> 3, j0 = (e4 & 7) * 4;
        const float p = (float)pos[m];
        f32x4 c, sn;
#pragma unroll
        for (int q = 0; q < 4; ++q) {
            const float invf = __builtin_amdgcn_exp2f(-(float)(2 * (j0 + q)) * (13.287712379549449f / 64.0f));
            const float ang = p * invf;
            double t = (double)ang * 0.15915494309189533577; t -= __builtin_rint(t);
            const float tf = (float)t;
            c[q] = __builtin_amdgcn_cosf(tf); sn[q] = __builtin_amdgcn_sinf(tf);
        }
        gst16f(ctab, ctab + (size_t)m * 32 + j0, c); gst16f(stab, stab + (size_t)m * 32 + j0, sn);
    }
}
__device__ __forceinline__ void final_norm_rows(Frame& F, float* x, const float* rss, int nslot, const float* gain) {
    const int gw = F.vcu * NWAVES + F.wave, NGW = F.G * NWAVES;
#ifdef MK_DIAG
    const float diag_scale = 1.f + 2.f * (float)__hip_atomic_load((unsigned*)F.ctl + CW_CODE, __ATOMIC_RELAXED, __HIP_MEMORY_SCOPE_AGENT);
#else
    const float diag_scale = 1.f;
#endif
    f32x4 gv[4];
#pragma unroll
    for (int j = 0; j < 4; ++j) gv[j] = *((const f32x4*)gain + F.lane + 64 * j);
    for (int m = gw; m < M; m += NGW) {
        const float r = diag_scale * __builtin_amdgcn_rsqf(wave_sum(F.lane < nslot ? gld4f(rss, rss + (size_t)m * nslot + F.lane) : 0.f) * (1.f / 1024.f) + EPS);
        f32x4* xr = (f32x4*)(x + (size_t)m * D) + F.lane;
#pragma unroll
        for (int j = 0; j < 4; ++j) gst16f(x, xr + 64 * j, gld16f(x, xr + 64 * j) * gv[j] * r);
    }
}

enum Phase { PH_PRO = 0, PH_UP00, PH_DN00, PH_UCONV, PH_SEND, PH_CARRY, PH_YG, PH_GLU, PH_UP01, PH_DN01, PH_DKV, PH_UP10, PH_DN10, PH_UKV, PH_DQ, PH_UQ, PH_ATTN, PH_WO, PH_UP11, PH_DN11, PH_FIN, PH_N };
__device__ __forceinline__ bool bar_after(int p) { return !(p == PH_DKV || p == PH_UKV || p == PH_FIN); }

template <int ph> __device__ __forceinline__ void phase_body(Frame& F, const Args& args, unsigned char* ws, const XcdBarrier& bar, int hi, unsigned char* lds) {
        int tid_ = threadIdx.x, bx_ = blockIdx.x; asm volatile("" : "+v"(tid_)); asm volatile("" : "+s"(bx_));
        { unsigned long long wsi = (unsigned long long)ws; asm volatile("" : "+s"(wsi) :: "memory"); ws = (unsigned char*)(GAS unsigned char*)wsi; }
        const LAS unsigned long long* PT = (const LAS unsigned long long*)(F.lds + PT_OFF);
#define INP(k) ((const float*)(const GAS float*)rfl64(PT[k]))
#define OUTP ((float*)(GAS float*)rfl64(PT[23]))
        F.tid = tid_; F.lane = tid_ & 63; F.wave = __builtin_amdgcn_readfirstlane(tid_ >> 6);
        F.vcu = (F.G % 8 == 0) ? (bx_ % 8) * (F.G / 8) + bx_ / 8 : bx_;
        F.ctl = (gu32*)(ws + WS_CTL);
        float* rss0 = (float*)(ws + WS_RSS);
#define RSP(id) ((float*)(ws + WS_RSP + rs_off(id)))
        bf16* xb = (bf16*)(ws + WS_XB); bf16* act = (bf16*)(ws + WS_ACT);
        bf16* Win_t = (bf16*)(ws + WS_WIN); bf16* Wout_t = (bf16*)(ws + WS_WOUT);
        float* ctab = (float*)(ws + WS_ROPE); float* stab = ctab + (size_t)M * 32;
        bf16* ug = (bf16*)(ws + WS_UG); bf16* yb = (bf16*)(ws + WS_Y); float* Send = (float*)(ws + WS_SEND); float* L16 = (float*)(ws + WS_L16);
        bf16* Kn = (bf16*)(ws + WS_KN); bf16* Vb = (bf16*)(ws + WS_V); bf16* Kr = (bf16*)(ws + WS_KR); bf16* lat = (bf16*)(ws + WS_LAT); bf16* cq = (bf16*)(ws + WS_CQ);
        bf16* Qb = (bf16*)(ws + WS_Q); bf16* Ob = (bf16*)(ws + WS_O);
        LAS pg8::EpiParams* ep = (LAS pg8::EpiParams*)(F.lds + EPI_OFF);
        LAS GemmParams* gp = (LAS GemmParams*)(F.lds + GP_OFF);
        const bool t0 = (tid_ == 0);
        if (t0) { gp->is_gemm = 0; gp->bgt = 1 << 30; gp->bgbytes = 0; gp->gM = M; gp->crot = 0; gp->gsz = 0; gp->cskip = 0; ep->rss_in = nullptr; ep->rss_out = nullptr; ep->rs_lds = 0; }
#define GP_SET(A_, Bt_, lda_, ldb_, K_, gN_) do { gp->is_gemm = 1; gp->A = (A_); gp->Bt = (Bt_); gp->lda = (lda_); gp->ldb = (ldb_); gp->K = (K_); gp->gN = (gN_); } while (0)
        switch (ph) {
        case PH_PRO: {
            LAS float* scr = (LAS float*)(F.lds + RING_OFF + F.wave * 16384);
            const bool tbl_wg = (F.G == 256) && ((F.vcu & 3) == 0);
            const int gw = (F.G == 256) ? (3 * (F.vcu >> 2) + (F.vcu & 3) - 1) * NWAVES + F.wave : F.vcu * NWAVES + F.wave, NGW = (F.G == 256 ? 192 : F.G) * NWAVES;
            constexpr int I_IN = (D / 64) * (2 * FF / 32), I_OUT = (FF / 64) * (D / 32), I_GLU = 16 * 64, I_DKV = 16 * 8, I_UKV = 4 * 64, I_DQ = 16 * 8, I_UQ = 4 * 48, I_O = 16 * 32;
            constexpr int NITEMS = 4 * I_IN + 4 * I_OUT + I_GLU + I_DKV + I_UKV + I_DQ + I_UQ + I_O;
            if (tbl_wg) s5_tables(F, F.vcu >> 2, INP(5), INP(6), INP(7), INP(8), INP(9), INP(10), INP(11), (bf16*)(ws + WS_TH), (bf16*)(ws + WS_GT), L16);
            else for (int it = gw; it < NITEMS; it += NGW) {
                int r = it; ConvJob j;
                if (r < 4 * I_IN) { const int idx = r / I_IN; r -= idx * I_IN; const int l = idx >> 1, jj = idx & 1;
                    j = ConvJob{INP(3) + (size_t)idx * D * 2 * FF, 2 * FF, D, D, 2 * FF, 1, INP(2) + (size_t)(l * 3 + (jj ? 2 : 0)) * D, Win_t + (size_t)idx * 2 * FF * D, D}; }
                else if ((r -= 4 * I_IN) < 4 * I_OUT) { const int idx = r / I_OUT; r -= idx * I_OUT;
                    j = ConvJob{INP(4) + (size_t)idx * FF * D, D, FF, FF, D, 0, nullptr, Wout_t + (size_t)idx * D * FF, FF}; }
                else if ((r -= 4 * I_OUT) < I_GLU) j = ConvJob{INP(13), 2048, 1024, 1024, 2048, 2, nullptr, (bf16*)(ws + WS_WGLU), 1024};
                else if ((r -= I_GLU) < I_DKV) j = ConvJob{INP(15), 192, 1024, 1024, 256, 3, INP(14), (bf16*)(ws + WS_WDKV), 1024};
                else if ((r -= I_DKV) < I_UKV) j = ConvJob{INP(17), 2048, 128, 256, 2048, 0, INP(16), (bf16*)(ws + WS_WUKV), P256};
                else if ((r -= I_UKV) < I_DQ) j = ConvJob{INP(18), 256, 1024, 1024, 256, 0, INP(2) + (size_t)(3 + 1) * D, (bf16*)(ws + WS_WDQ), 1024};
                else if ((r -= I_DQ) < I_UQ) j = ConvJob{INP(20), 1536, 256, 256, 1536, 4, INP(19), (bf16*)(ws + WS_WUQ), P256};
                else { r -= I_UQ; j = ConvJob{INP(21), 1024, 1024, 1024, 1024, 0, nullptr, (bf16*)(ws + WS_WO), 1024}; }
                conv_job_item(j, r, scr, F.lane);
            }
            __syncthreads();
            xconv_rows(F, INP(0), xb, rss0);
            rope_tables(F, (const int*)INP(1), ctab, stab);
            if (F.G != 256 && (F.vcu & 3) == 0 && (F.vcu >> 2) < NG)
                s5_tables(F, F.vcu >> 2, INP(5), INP(6), INP(7), INP(8), INP(9), INP(10), INP(11), (bf16*)(ws + WS_TH), (bf16*)(ws + WS_GT), L16);
            { const int gt = F.vcu * (NWAVES * 64) + F.tid, NT = F.G * NWAVES * 64;
              for (int e = gt; e < M * 16; e += NT) { const int m = e >> 4, c = e & 15; gst16(lat, lat + (size_t)m * P256 + 128 + c * 8, (v4u){0u, 0u, 0u, 0u}); } }
        } break;
        case PH_UP00: case PH_UP01: case PH_UP10: case PH_UP11:
#ifdef MK_DIAG
            if (ph == PH_UP00 && hi - ph > 1 && ph > 0 || (ph == PH_UP00 && hi > 1 && ph == 1)) {
                const int m = bx_ * 64 + (tid_ >> 3), c = (tid_ & 7) * 128 + 6;
                const float* xin = INP(0);
                const unsigned want = pk2(xin[(size_t)m * D + c], xin[(size_t)m * D + c + 1]);
                const unsigned got_plain = *(const volatile unsigned*)(xb + (size_t)m * D + c);
                const unsigned got_sc1 = __hip_atomic_load((const unsigned*)(xb + (size_t)m * D + c), __ATOMIC_RELAXED, __HIP_MEMORY_SCOPE_SYSTEM);
                if (got_sc1 != want) atomicMax((unsigned*)F.ctl + CW_CODE, 3u);
                else if (got_plain != want) atomicMax((unsigned*)F.ctl + CW_CODE, 2u);
            }
#endif
#ifdef DIAG_RSSFIX
            if (ph == PH_UP01 && hi - ph > 1 && ph > 0) { rss_rows(F, OUTP, RSP(RS_X2)); GRID_BARRIER(); }
#endif
            {
            const int idx = (ph == PH_UP00) ? 0 : (ph == PH_UP01) ? 1 : (ph == PH_UP10) ? 2 : 3;
            const int rsi = (ph == PH_UP00) ? RS_X0 : (ph == PH_UP01) ? RS_X2 : (ph == PH_UP10) ? RS_X3 : RS_X5;
            const float* rsp = (rsi == RS_X0) ? rss0 : (rsi == RS_X2) ? RSP(RS_X2) : (rsi == RS_X3) ? RSP(RS_X3) : RSP(RS_X5);
            if (F.G == 256) {
                const int ns = rs_slots(rsi), r0 = (bx_ & 7) * 2048 + tid_ * 4;
                f32x4 sq = (f32x4){0.f, 0.f, 0.f, 0.f};
                if (ns == 1) sq = gld16f(rsp, rsp + r0);
                else {
#pragma unroll
                    for (int rr = 0; rr < 4; ++rr) { float a = 0.f;
                        for (int q = 0; q < ns; q += 4) { const f32x4 v = gld16f(rsp, rsp + (size_t)(r0 + rr) * ns + q); a += (v[0] + v[1]) + (v[2] + v[3]); }
                        sq[rr] = a; }
                }
                f32x4 rsv;
#pragma unroll
                for (int rr = 0; rr < 4; ++rr) rsv[rr] = __builtin_amdgcn_rsqf(sq[rr] * (1.f / 1024.f) + EPS);
                *(LAS f32x4*)(F.lds + RSL_OFF + tid_ * 16) = rsv;
            }
            if (t0) {
            GP_SET(xb, Win_t + (size_t)idx * 2 * FF * D, D, D, D, 2 * FF);
            ep->mode = pg8::EM_SWIGLU; ep->rss_n = rs_slots(rsi); ep->inv_k = 1.f / 1024.f;
            if (F.G == 256) { ep->rss_in = nullptr; ep->rs_lds = RSL_OFF - EPI_OFF; } else ep->rss_in = rsp; ep->ob = act; ep->ldo = FF;
            } }
            break;
        case PH_DN00: case PH_DN01: case PH_DN10: case PH_DN11: if (t0) {
            const int idx = (ph == PH_DN00) ? 0 : (ph == PH_DN01) ? 1 : (ph == PH_DN10) ? 2 : 3;
            const int rso = (ph == PH_DN00) ? RS_X1 : (ph == PH_DN01) ? RS_X3 : (ph == PH_DN10) ? RS_X4 : RS_X6;
            GP_SET(act, Wout_t + (size_t)idx * D * FF, FF, FF, FF, D);
            ep->mode = pg8::EM_RES; ep->base = (ph == PH_DN00) ? INP(0) : OUTP; ep->out = OUTP; ep->alpha = 0.5f; ep->ob = xb; ep->rss_out = (rso == RS_X1) ? RSP(RS_X1) : (rso == RS_X3) ? RSP(RS_X3) : (rso == RS_X4) ? RSP(RS_X4) : RSP(RS_X6);
        } break;
        case PH_UCONV: uconv_rows(F, OUTP, RSP(RS_X1), rs_slots(RS_X1), INP(2) + 1 * D, ug); break;
        case PH_SEND: if (t0) {
            GP_SET(ug, (const bf16*)(ws + WS_GT), 384, 256, 256, 256); gp->gM = NG * 1024; gp->bgt = 4; gp->bgbytes = (size_t)256 * 256 * 2;
            ep->mode = pg8::EM_SEND; ep->fout = Send;
        } break;
        case PH_CARRY: carry_scan(F, Send, L16, ug); break;
        case PH_YG: if (t0) {
            GP_SET(ug, (const bf16*)(ws + WS_TH), 384, 384, 384, 256); gp->gM = NG * 1024; gp->bgt = 4; gp->bgbytes = (size_t)256 * 384 * 2;
            ep->mode = pg8::EM_Y; ep->ua = ug; ep->aux0 = INP(12); ep->ob = yb;
        } break;
        case PH_GLU: if (t0) {
            GP_SET(yb, (const bf16*)(ws + WS_WGLU), D, D, D, 2048);
            ep->mode = pg8::EM_GLU; ep->base = OUTP; ep->out = OUTP; ep->ob = xb; ep->rss_out = RSP(RS_X2);
        } break;
        case PH_DKV: if (t0) {
            GP_SET(xb, (const bf16*)(ws + WS_WDKV), D, D, D, 256); gp->crot = 128;
            ep->mode = pg8::EM_DKV; ep->rss_in = RSP(RS_X3); ep->rss_n = rs_slots(RS_X3); ep->inv_k = 1.f / 1024.f; ep->ob = lat; ep->ob2 = Kr; ep->rss_out = RSP(RS_LAT); ep->aux0 = ctab; ep->aux1 = stab;
        } break;
        case PH_UKV: if (t0) {
            GP_SET(lat, (const bf16*)(ws + WS_WUKV), P256, P256, 256, 2048); if (F.G == 256) { gp->gsz = 192; gp->cskip = 64; }
            ep->mode = pg8::EM_UKV; ep->rss_in = RSP(RS_LAT); ep->rss_n = rs_slots(RS_LAT); ep->inv_k = 1.f / 128.f; ep->ob = Kn; ep->ob2 = Vb;
        } break;
        case PH_DQ: if (t0) {
            GP_SET(xb, (const bf16*)(ws + WS_WDQ), D, D, D, 256);
            ep->mode = pg8::EM_DQ; ep->rss_in = RSP(RS_X4); ep->rss_n = rs_slots(RS_X4); ep->inv_k = 1.f / 1024.f; ep->ob = cq; ep->rss_out = RSP(RS_Q);
        } break;
        case PH_UQ: if (t0) {
            GP_SET(cq, (const bf16*)(ws + WS_WUQ), P256, P256, 256, 1536);
            ep->mode = pg8::EM_UQ; ep->rss_in = RSP(RS_Q); ep->rss_n = rs_slots(RS_Q); ep->inv_k = 1.f / 256.f; ep->ob = Qb; ep->alpha = QSCALE; ep->aux0 = ctab; ep->aux1 = stab;
        } break;
        case PH_ATTN: attn::attn_phase((char*)lds + RING_OFF, Qb, Kn, Kr, Vb, Ob, F.vcu, F.G, tid_); break;
        case PH_WO: if (t0) {
            GP_SET(Ob, (const bf16*)(ws + WS_WO), D, D, D, D);
            ep->mode = pg8::EM_RES; ep->base = OUTP; ep->out = OUTP; ep->alpha = 1.0f; ep->ob = xb; ep->rss_out = RSP(RS_X5);
        } break;
        case PH_FIN: final_norm_rows(F, OUTP, RSP(RS_X6), rs_slots(RS_X6), INP(22)); break;
        default: break;
        }
#undef GP_SET
#undef INP
#undef OUTP
        __syncthreads();
        if (__builtin_amdgcn_readfirstlane(gp->is_gemm)) {
            pg8::Gemm g;
            g.A = (const bf16*)(const GAS bf16*)rfl64((unsigned long long)gp->A); g.Bt = (const bf16*)(const GAS bf16*)rfl64((unsigned long long)gp->Bt);
            g.lda = __builtin_amdgcn_readfirstlane(gp->lda); g.ldb = __builtin_amdgcn_readfirstlane(gp->ldb); g.K = __builtin_amdgcn_readfirstlane(gp->K);
            g.bgt = __builtin_amdgcn_readfirstlane(gp->bgt); g.bgbytes = (size_t)rfl64((unsigned long long)gp->bgbytes);
            const int gM = __builtin_amdgcn_readfirstlane(gp->gM), gN = __builtin_amdgcn_readfirstlane(gp->gN), crot = __builtin_amdgcn_readfirstlane(gp->crot);
            const int gsz = __builtin_amdgcn_readfirstlane(gp->gsz), cskip = __builtin_amdgcn_readfirstlane(gp->cskip);
            const int cc = (int)((bx_ + crot) % F.G) - cskip;
            if (cc >= 0) {
                pg8::StaticOrder S; S.init(gM, gN, gsz ? gsz : F.G, cc);
                pg8::EpiDyn ED{(const LAS pg8::EpiParams*)(F.lds + EPI_OFF)};
                pg8::gemm_phase<pg8::EpiDyn, pg8::StaticOrder, true, true>(F.lds + RING_OFF, g, S, ED, tid_);
            }
        }
        if (ph + 1 < hi && bar_after(ph)) { GRID_BARRIER();
#ifdef DUP_BAR
            GRID_BARRIER();
#endif
        }
        __syncthreads();
}

__global__ void __launch_bounds__(NWAVES * 64, 2) mk_fwd(Args args) {
    extern __shared__ __attribute__((aligned(16))) unsigned char lds[];
    Frame F;
    F.lds = (LAS unsigned char*)lds;
    F.MISC = (volatile LAS unsigned*)(F.lds + MISC_OFF);
    F.tid = threadIdx.x; F.lane = F.tid & 63; F.wave = __builtin_amdgcn_readfirstlane(F.tid >> 6);
    F.G = gridDim.x; { const int bx = blockIdx.x; F.vcu = (F.G % 8 == 0) ? (bx % 8) * (F.G / 8) + bx / 8 : bx; }
    unsigned char* ws = args.ws;
    F.ctl = (gu32*)(ws + WS_CTL);
    for (int u = F.tid; u < (LDS_BYTES - LDSCTL_OFF) / 4; u += NWAVES * 64) ((LAS unsigned*)(F.lds + LDSCTL_OFF))[u] = 0u;
    __syncthreads();
    if (F.tid == 0) { LAS unsigned long long* pt = (LAS unsigned long long*)(F.lds + PT_OFF);
        pt[0] = (unsigned long long)args.in[0];
        pt[1] = (unsigned long long)args.in[1];
        pt[2] = (unsigned long long)args.in[2];
        pt[3] = (unsigned long long)args.in[3];
        pt[4] = (unsigned long long)args.in[4];
        pt[5] = (unsigned long long)args.in[5];
        pt[6] = (unsigned long long)args.in[6];
        pt[7] = (unsigned long long)args.in[7];
        pt[8] = (unsigned long long)args.in[8];
        pt[9] = (unsigned long long)args.in[9];
        pt[10] = (unsigned long long)args.in[10];
        pt[11] = (unsigned long long)args.in[11];
        pt[12] = (unsigned long long)args.in[12];
        pt[13] = (unsigned long long)args.in[13];
        pt[14] = (unsigned long long)args.in[14];
        pt[15] = (unsigned long long)args.in[15];
        pt[16] = (unsigned long long)args.in[16];
        pt[17] = (unsigned long long)args.in[17];
        pt[18] = (unsigned long long)args.in[18];
        pt[19] = (unsigned long long)args.in[19];
        pt[20] = (unsigned long long)args.in[20];
        pt[21] = (unsigned long long)args.in[21];
        pt[22] = (unsigned long long)args.in[22];
        pt[23] = (unsigned long long)args.out; }
    __syncthreads();
    XcdBarrier bar; bar.bar = (unsigned*)(F.ctl + CW_BAR) + args.li * XCD_BAR_WORDS; bar.x = 0; bar.st = nullptr;
    const int lo = args.ph_lo, hi = args.ph_hi;
#ifdef MK_SIMPLE_BAR
    if (hi - lo > 1) sb_begin((unsigned*)F.ctl);
#else
    if (hi - lo > 1) bar = xcd_barrier_post((unsigned*)(F.ctl + CW_BAR) + args.li * XCD_BAR_WORDS, F.MISC + 8);
#endif


    if (lo <= 0 && 0 < hi) { phase_body<0>(F, args, ws, bar, hi, lds);
#if defined(DUP_PH) && DUP_PH == 0
        phase_body<0>(F, args, ws, bar, hi, lds);
#endif
    }
    if (lo <= 1 && 1 < hi) { phase_body<1>(F, args, ws, bar, hi, lds);
#if defined(DUP_PH) && DUP_PH == 1
        phase_body<1>(F, args, ws, bar, hi, lds);
#endif
    }
    if (lo <= 2 && 2 < hi) { phase_body<2>(F, args, ws, bar, hi, lds);
#if defined(DUP_PH) && DUP_PH == 2
        phase_body<2>(F, args, ws, bar, hi, lds);
#endif
    }
    if (lo <= 3 && 3 < hi) { phase_body<3>(F, args, ws, bar, hi, lds);
#if defined(DUP_PH) && DUP_PH == 3
        phase_body<3>(F, args, ws, bar, hi, lds);
#endif
    }
    if (lo <= 4 && 4 < hi) { phase_body<4>(F, args, ws, bar, hi, lds);
#if defined(DUP_PH) && DUP_PH == 4
        phase_body<4>(F, args, ws, bar, hi, lds);
#endif
    }
    if (lo <= 5 && 5 < hi) { phase_body<5>(F, args, ws, bar, hi, lds);
#if defined(DUP_PH) && DUP_PH == 5
        phase_body<5>(F, args, ws, bar, hi, lds);
#endif
    }
    if (lo <= 6 && 6 < hi) { phase_body<6>(F, args, ws, bar, hi, lds);
#if defined(DUP_PH) && DUP_PH == 6
        phase_body<6>(F, args, ws, bar, hi, lds);
#endif
#if defined(DUP_S5)
        phase_body<3>(F, args, ws, bar, hi, lds); phase_body<4>(F, args, ws, bar, hi, lds); phase_body<5>(F, args, ws, bar, hi, lds); phase_body<6>(F, args, ws, bar, hi, lds);
#endif
    }
    if (lo <= 7 && 7 < hi) { phase_body<7>(F, args, ws, bar, hi, lds);
#if defined(DUP_PH) && DUP_PH == 7
        phase_body<7>(F, args, ws, bar, hi, lds);
#endif
    }
    if (lo <= 8 && 8 < hi) { phase_body<8>(F, args, ws, bar, hi, lds);
#if defined(DUP_PH) && DUP_PH == 8
        phase_body<8>(F, args, ws, bar, hi, lds);
#endif
    }
    if (lo <= 9 && 9 < hi) { phase_body<9>(F, args, ws, bar, hi, lds);
#if defined(DUP_PH) && DUP_PH == 9
        phase_body<9>(F, args, ws, bar, hi, lds);
#endif
    }
    if (lo <= 10 && 10 < hi) { phase_body<10>(F, args, ws, bar, hi, lds);
#if defined(DUP_PH) && DUP_PH == 10
        phase_body<10>(F, args, ws, bar, hi, lds);
#endif
    }
    if (lo <= 11 && 11 < hi) { phase_body<11>(F, args, ws, bar, hi, lds);
#if defined(DUP_PH) && DUP_PH == 11
        phase_body<11>(F, args, ws, bar, hi, lds);
#endif
    }
    if (lo <= 12 && 12 < hi) { phase_body<12>(F, args, ws, bar, hi, lds);
#if defined(DUP_PH) && DUP_PH == 12
        phase_body<12>(F, args, ws, bar, hi, lds);
#endif
    }
    if (lo <= 13 && 13 < hi) { phase_body<13>(F, args, ws, bar, hi, lds);
#if defined(DUP_PH) && DUP_PH == 13
        phase_body<13>(F, args, ws, bar, hi, lds);
#endif
    }
    if (lo <= 14 && 14 < hi) { phase_body<14>(F, args, ws, bar, hi, lds);
#if defined(DUP_PH) && DUP_PH == 14
        phase_body<14>(F, args, ws, bar, hi, lds);
#endif
    }
    if (lo <= 15 && 15 < hi) { phase_body<15>(F, args, ws, bar, hi, lds);
#if defined(DUP_PH) && DUP_PH == 15
        phase_body<15>(F, args, ws, bar, hi, lds);
#endif
    }
    if (lo <= 16 && 16 < hi) { phase_body<16>(F, args, ws, bar, hi, lds);
#if defined(DUP_PH) && DUP_PH == 16
        phase_body<16>(F, args, ws, bar, hi, lds);
#endif
    }
    if (lo <= 17 && 17 < hi) { phase_body<17>(F, args, ws, bar, hi, lds);
#if defined(DUP_PH) && DUP_PH == 17
        phase_body<17>(F, args, ws, bar, hi, lds);
#endif
    }
    if (lo <= 18 && 18 < hi) { phase_body<18>(F, args, ws, bar, hi, lds);
#if defined(DUP_PH) && DUP_PH == 18
        phase_body<18>(F, args, ws, bar, hi, lds);
#endif
    }
    if (lo <= 19 && 19 < hi) { phase_body<19>(F, args, ws, bar, hi, lds);
#if defined(DUP_PH) && DUP_PH == 19
        phase_body<19>(F, args, ws, bar, hi, lds);
#endif
    }
    if (lo <= 20 && 20 < hi) { phase_body<20>(F, args, ws, bar, hi, lds);
#if defined(DUP_PH) && DUP_PH == 20
        phase_body<20>(F, args, ws, bar, hi, lds);
#endif
    }
#ifdef MK_SIMPLE_BAR
    if (hi - lo > 1) sb_end((unsigned*)F.ctl);
#endif
}

__global__ void __launch_bounds__(256) dg_cksum(const unsigned* p, size_t nwords, unsigned long long* out, int slot) {
    if (blockIdx.x == 0 && threadIdx.x == 0 && slot < 0) { out[0] = 0; out[1] = 0; }
    if (slot < 0) return;
    unsigned long long s = 0;
    for (size_t i = (size_t)blockIdx.x * 256 + threadIdx.x; i < nwords; i += (size_t)gridDim.x * 256) s += (unsigned long long)p[i] * (unsigned long long)(2 * (i & 0xffff) + 1);
    for (int o = 1; o < 64; o <<= 1) s += __shfl_xor(s, o);
    if ((threadIdx.x & 63) == 0) atomicAdd(out + slot, s);
}
__global__ void __launch_bounds__(256) dg_fill(unsigned* p, size_t nwords, unsigned pat) {
    for (size_t i = (size_t)blockIdx.x * 256 + threadIdx.x; i < nwords; i += (size_t)gridDim.x * 256) p[i] = pat;
}
__global__ void dg_cmp(const unsigned long long* c, unsigned* code) { if (threadIdx.x == 0) code[0] = (c[0] != c[1]) ? 1u : 0u; }
__global__ void __launch_bounds__(256) dg_nan_if(const unsigned long long* c, float* out, size_t n) {
    if (c[0] == c[1]) return;
    for (size_t i = (size_t)blockIdx.x * 256 + threadIdx.x; i < n; i += (size_t)gridDim.x * 256) out[i] = __builtin_nanf("");
}

extern "C" void kernel_launch(void* const* d_in, const int* in_sizes, int n_in, void* d_out, int out_size, void* d_ws, size_t ws_size, hipStream_t stream) {
    static int grid = 0;
    if (grid == 0) {
        if (n_in != 23 || in_sizes[0] != M * D || out_size != M * D || ws_size < WS_END) { fprintf(stderr, "kernel_launch: unexpected shapes / workspace (%d inputs, ws %zu)\n", n_in, ws_size); grid = -1; return; }
        int dev = 0, cus = 0;
        if (hipGetDevice(&dev) != hipSuccess || hipDeviceGetAttribute(&cus, hipDeviceAttributeMultiprocessorCount, dev) != hipSuccess) { grid = -1; return; }
        if (hipFuncSetAttribute((const void*)mk_fwd, hipFuncAttributeMaxDynamicSharedMemorySize, LDS_BYTES) != hipSuccess) { fprintf(stderr, "kernel_launch: hipFuncSetAttribute failed\n"); grid = -1; return; }
        int per_cu = 0;
        if (hipOccupancyMaxActiveBlocksPerMultiprocessor(&per_cu, (const void*)mk_fwd, NWAVES * 64, LDS_BYTES) != hipSuccess || per_cu < 1) fprintf(stderr, "kernel_launch: occupancy query says %d\n", per_cu);
        (void)hipGetLastError();
        grid = cus;
    }
    if (grid < 0) return;
    if (hipMemsetAsync((char*)d_ws + WS_CTL, 0, CTL_ZERO_BYTES, stream) != hipSuccess) return;
    Args a{};
    for (int i = 0; i < 23; ++i) a.in[i] = (const float*)d_in[i];
    a.out = (float*)d_out; a.ws = (unsigned char*)d_ws;
#if MK_MODE == 0
    a.ph_lo = 0; a.ph_hi = PH_N; a.li = 0;
    hipLaunchKernelGGL(mk_fwd, dim3(grid), dim3(NWAVES * 64), LDS_BYTES, stream, a);
#elif MK_MODE == 1
    for (int p = 0; p < PH_N; ++p) { a.ph_lo = p; a.ph_hi = p + 1; a.li = 0; hipLaunchKernelGGL(mk_fwd, dim3(grid), dim3(NWAVES * 64), LDS_BYTES, stream, a); }
#elif MK_MODE == 4
    unsigned long long* ck = (unsigned long long*)((char*)d_ws + WS_CTL + 512 * 1024);
    hipLaunchKernelGGL(dg_cksum, dim3(1), dim3(256), 0, stream, (const unsigned*)nullptr, (size_t)0, ck, -1);
    for (int pass = 0; pass < 2; ++pass) {
        hipLaunchKernelGGL(dg_fill, dim3(4096), dim3(256), 0, stream, (unsigned*)((char*)d_ws + 1 * MiB), (size_t)(WS_END - 1 * MiB) / 4, pass ? 0x33333333u : 0x55555555u);
        hipLaunchKernelGGL(dg_fill, dim3(4096), dim3(256), 0, stream, (unsigned*)d_out, (size_t)M * D, pass ? 0x77777777u : 0x11111111u);
        for (int p = 0; p < PH_N; ) {
            if (p == MK_CUT_LO) { a.ph_lo = MK_CUT_LO; a.ph_hi = MK_CUT_HI; p = MK_CUT_HI; } else { a.ph_lo = p; a.ph_hi = p + 1; ++p; }
            a.li = 0; hipLaunchKernelGGL(mk_fwd, dim3(grid), dim3(NWAVES * 64), LDS_BYTES, stream, a);
            if (a.ph_hi - a.ph_lo > 1) (void)hipMemsetAsync((char*)d_ws + WS_CTL + CW_BAR * 4, 0, XCD_BAR_WORDS * 4, stream);
        }
        hipLaunchKernelGGL(dg_cksum, dim3(1024), dim3(256), 0, stream, (const unsigned*)d_out, (size_t)M * D, ck, pass);
    }
    hipLaunchKernelGGL(dg_nan_if, dim3(1024), dim3(256), 0, stream, (const unsigned long long*)ck, (float*)d_out, (size_t)M * D);
#elif MK_MODE == 3
    unsigned long long* ck = (unsigned long long*)((char*)d_ws + WS_CTL + 512 * 1024);
    unsigned* code = (unsigned*)((char*)d_ws + WS_CTL) + CW_CODE;
    hipLaunchKernelGGL(dg_cksum, dim3(1), dim3(256), 0, stream, (const unsigned*)nullptr, (size_t)0, ck, -1);
    for (int p = MK_CUT_LO; p < MK_CUT_HI; ++p) { a.ph_lo = p; a.ph_hi = p + 1; hipLaunchKernelGGL(mk_fwd, dim3(grid), dim3(NWAVES * 64), LDS_BYTES, stream, a); }
    hipLaunchKernelGGL(dg_cksum, dim3(1024), dim3(256), 0, stream, (const unsigned*)((char*)d_ws + WS_ACT), (size_t)M * FF / 2, ck, 0);
#if defined(DG_SCRAMBLE) && DG_SCRAMBLE == 1
    hipLaunchKernelGGL(dg_fill, dim3(2048), dim3(256), 0, stream, (unsigned*)((char*)d_ws + WS_XB), (size_t)M * D / 2, 0x3f803f80u);
#elif defined(DG_SCRAMBLE) && DG_SCRAMBLE == 2
    hipLaunchKernelGGL(dg_fill, dim3(2048), dim3(256), 0, stream, (unsigned*)((char*)d_ws + WS_WIN), (size_t)2 * FF * D / 2, 0x3c003c00u);
#elif defined(DG_SCRAMBLE) && DG_SCRAMBLE == 3
    hipLaunchKernelGGL(dg_fill, dim3(64), dim3(256), 0, stream, (unsigned*)((char*)d_ws + WS_RSS), (size_t)M, 0x44800000u);
#endif
    a.ph_lo = MK_CUT_LO; a.ph_hi = MK_CUT_HI; hipLaunchKernelGGL(mk_fwd, dim3(grid), dim3(NWAVES * 64), LDS_BYTES, stream, a);
    hipLaunchKernelGGL(dg_cksum, dim3(1024), dim3(256), 0, stream, (const unsigned*)((char*)d_ws + WS_ACT), (size_t)M * FF / 2, ck, 1);
    hipLaunchKernelGGL(dg_cmp, dim3(1), dim3(64), 0, stream, (const unsigned long long*)ck, code);
    for (int p = MK_CUT_HI; p < PH_N; ++p) { a.ph_lo = p; a.ph_hi = p + 1; hipLaunchKernelGGL(mk_fwd, dim3(grid), dim3(NWAVES * 64), LDS_BYTES, stream, a); }
#else
    for (int p = 0; p < PH_N; ) {
        if (p == MK_CUT_LO) { a.ph_lo = MK_CUT_LO; a.ph_hi = MK_CUT_HI; p = MK_CUT_HI; } else { a.ph_lo = p; a.ph_hi = p + 1; ++p; }
        a.li = 0; hipLaunchKernelGGL(mk_fwd, dim3(grid), dim3(NWAVES * 64), LDS_BYTES, stream, a);
        if (a.ph_hi - a.ph_lo > 1 && p < PH_N) (void)hipMemsetAsync((char*)d_ws + WS_CTL + CW_BAR * 4, 0, XCD_BAR_WORDS * 4, stream);
    }
#endif
}
```

```cpp
#include <hip/hip_runtime.h>
#include <hip/hip_bf16.h>
#include <cstdio>
#include <cstdint>
#include <cmath>

#ifndef MK_MODE
#define MK_MODE 0
#endif
#ifndef MK_CUT_LO
#define MK_CUT_LO 0
#define MK_CUT_HI 2
#endif

constexpr int BATCH = 8, SEQ = 2048, D = 1024, M = BATCH * SEQ, FF = 2816, NG = 64, NP = 64, NH = 8;
constexpr float EPS = 1e-6f;
constexpr float QSCALE = 0.07216878364870323f * 1.4426950408889634f;
constexpr int NWAVES = 8;
constexpr int P256 = 320;

constexpr size_t MiB = 1u << 20;
constexpr size_t WS_CTL = 0, CTL_ZERO_BYTES = 65536;
constexpr size_t WS_RSS = 1 * MiB;
constexpr size_t WS_WIN = 2 * MiB;
constexpr size_t WIN_BYTES = (size_t)2 * FF * D * 2;
constexpr size_t WS_WOUT = WS_WIN + 4 * WIN_BYTES;
constexpr size_t WOUT_BYTES = (size_t)D * FF * 2;
constexpr size_t WS_WGLU = WS_WOUT + 4 * WOUT_BYTES;
constexpr size_t WS_WDKV = WS_WGLU + (size_t)2048 * 1024 * 2;
constexpr size_t WS_WUKV = WS_WDKV + (size_t)256 * 1024 * 2;
constexpr size_t WS_WDQ = WS_WUKV + (size_t)2048 * P256 * 2;
constexpr size_t WS_WUQ = WS_WDQ + (size_t)256 * 1024 * 2;
constexpr size_t WS_WO = WS_WUQ + (size_t)1536 * P256 * 2;
constexpr size_t WS_WEND = WS_WO + (size_t)1024 * 1024 * 2;
static_assert(WS_WEND <= 78 * MiB, "weights");
constexpr size_t WS_TH = 78 * MiB;
constexpr size_t WS_GT = 90 * MiB;
constexpr size_t WS_ROPE = 98 * MiB;
constexpr size_t WS_L16 = 256 * 1024;
constexpr size_t WS_XB = 102 * MiB;
constexpr size_t WS_ACT = 134 * MiB;
constexpr size_t WS_Q = WS_ACT, WS_O = WS_ACT + 48 * MiB;
constexpr size_t WS_R2 = 222 * MiB;
constexpr size_t WS_UG = WS_R2, WS_Y = WS_R2 + 48 * MiB, WS_SEND = WS_R2 + 80 * MiB;
constexpr size_t WS_KN = WS_R2, WS_V = WS_R2 + 32 * MiB, WS_KR = WS_R2 + 64 * MiB, WS_LAT = WS_R2 + 66 * MiB, WS_CQ = WS_R2 + 78 * MiB;
constexpr size_t WS_RSP = 334 * MiB;
constexpr size_t WS_END = 342 * MiB;
static_assert(WS_ROPE + (size_t)M * 32 * 4 * 2 <= WS_XB && WS_L16 >= CTL_ZERO_BYTES && WS_L16 + 32768 <= 512 * 1024, "rope tables / l16 placement");

constexpr int CW_TMO = 0, CW_CODE = 1, CW_BAR = 4096;
enum { RS_X0 = 0, RS_X1, RS_X2, RS_X3, RS_X4, RS_X5, RS_X6, RS_LAT, RS_Q, RS_N };
__host__ __device__ constexpr int rs_slots(int id) { return id == RS_X0 ? 1 : id == RS_X2 ? 32 : (id == RS_LAT || id == RS_Q) ? 4 : 16; }
__host__ __device__ constexpr size_t rs_off(int id) { size_t o = 0; for (int i = 1; i < id; ++i) o += (size_t)M * rs_slots(i) * 4; return o; }
static_assert(rs_off(RS_N) <= 8 * MiB, "partial-sum arrays");

constexpr int RING_OFF = 0, RING_BYTES = 131072;
constexpr int LDSCTL_OFF = RING_BYTES, MISC_OFF = LDSCTL_OFF + 320;
constexpr int EPI_OFF = MISC_OFF + 128, GP_OFF = EPI_OFF + 128, PT_OFF = GP_OFF + 80;
constexpr int RSL_OFF = (PT_OFF + 24 * 8 + 15) / 16 * 16;
constexpr int LDS_BYTES = 147456;
static_assert(RSL_OFF + 8192 <= LDS_BYTES, "row-scale table");

#define GAS __attribute__((address_space(1)))
#define LAS __attribute__((address_space(3)))
typedef unsigned short bf16;
typedef unsigned v4u __attribute__((ext_vector_type(4)));
typedef unsigned v2u __attribute__((ext_vector_type(2)));
typedef float f32x4 __attribute__((ext_vector_type(4)));
typedef float f32x2 __attribute__((ext_vector_type(2)));
typedef short bf16x8 __attribute__((ext_vector_type(8)));
typedef GAS unsigned gu32;
#define RLX_AGENT __ATOMIC_RELAXED, __HIP_MEMORY_SCOPE_AGENT
#define LDS_WAIT() asm volatile("s_waitcnt lgkmcnt(0)" ::: "memory")
#define VM_WAIT() asm volatile("s_waitcnt vmcnt(0)" ::: "memory")
typedef _Float16 h16x2 __attribute__((ext_vector_type(2)));
typedef _Float16 h16x8 __attribute__((ext_vector_type(8)));
__device__ __forceinline__ unsigned f2bf(float f) { return (unsigned)__builtin_bit_cast(unsigned short, (_Float16)f); }
__device__ __forceinline__ unsigned pk2(float lo, float hi) { const h16x2 v = {(_Float16)lo, (_Float16)hi}; return __builtin_bit_cast(unsigned, v); }
__device__ __forceinline__ float bf2f(unsigned h) { return (float)__builtin_bit_cast(_Float16, (unsigned short)h); }
__device__ __forceinline__ float wave_sum(float v) {
#pragma unroll
    for (int o = 1; o < 64; o <<= 1) v += __shfl_xor(v, o);
    return v;
}


#ifdef MK_BYPASS
typedef __amdgpu_buffer_rsrc_t brs_t;
#define AUXS 17
__device__ __forceinline__ brs_t mkb(const void* p) {
    const unsigned long long v = (unsigned long long)p; const unsigned lo = __builtin_amdgcn_readfirstlane((unsigned)v), hi = __builtin_amdgcn_readfirstlane((unsigned)(v >> 32));
    return __builtin_amdgcn_make_buffer_rsrc((void*)(((unsigned long long)hi << 32) | lo), 0, 0x7fffffff, 0x00020000); }
__device__ __forceinline__ unsigned boff(const void* base, const void* p) { return (unsigned)((const char*)p - (const char*)base); }
__device__ __forceinline__ v4u gld16(const void* base, const void* p) { return __builtin_amdgcn_raw_buffer_load_b128(mkb(base), boff(base, p), 0, AUXS); }
__device__ __forceinline__ unsigned gld4(const void* base, const void* p) { return __builtin_amdgcn_raw_buffer_load_b32(mkb(base), boff(base, p), 0, AUXS); }
__device__ __forceinline__ void gst16(void* base, void* p, v4u v) { __builtin_amdgcn_raw_buffer_store_b128(v, mkb(base), boff(base, p), 0, AUXS); }
__device__ __forceinline__ void gst8(void* base, void* p, v2u v) { __builtin_amdgcn_raw_buffer_store_b64(v, mkb(base), boff(base, p), 0, AUXS); }
__device__ __forceinline__ void gst4(void* base, void* p, unsigned v) { __builtin_amdgcn_raw_buffer_store_b32(v, mkb(base), boff(base, p), 0, AUXS); }
__device__ __forceinline__ void gst2(void* base, void* p, unsigned short v) { __builtin_amdgcn_raw_buffer_store_b16(v, mkb(base), boff(base, p), 0, AUXS); }
#else
__device__ __forceinline__ v4u gld16(const void*, const void* p) { return *(const GAS v4u*)(unsigned long long)p; }
__device__ __forceinline__ unsigned gld4(const void*, const void* p) { return *(const GAS unsigned*)(unsigned long long)p; }
__device__ __forceinline__ void gst16(void*, void* p, v4u v) { *(GAS v4u*)(unsigned long long)p = v; }
__device__ __forceinline__ void gst8(void*, void* p, v2u v) { *(GAS v2u*)(unsigned long long)p = v; }
__device__ __forceinline__ void gst4(void*, void* p, unsigned v) { *(GAS unsigned*)(unsigned long long)p = v; }
__device__ __forceinline__ void gst2(void*, void* p, unsigned short v) { *(GAS unsigned short*)(unsigned long long)p = v; }
#endif
__device__ __forceinline__ f32x4 gld16f(const void* base, const void* p) { return __builtin_bit_cast(f32x4, gld16(base, p)); }
__device__ __forceinline__ float gld4f(const void* base, const void* p) { return __builtin_bit_cast(float, gld4(base, p)); }
__device__ __forceinline__ void gst16f(void* base, void* p, f32x4 v) { gst16(base, p, __builtin_bit_cast(v4u, v)); }
__device__ __forceinline__ void gst4f(void* base, void* p, float v) { gst4(base, p, __builtin_bit_cast(unsigned, v)); }

#ifdef DG_LDSDMA_AUX
#define PG8_AUX DG_LDSDMA_AUX
#else
#define PG8_AUX 0
#endif
namespace pg8 {
#define PG8_LAS __attribute__((address_space(3)))
typedef unsigned short bf16_t;
typedef short bf16x8 __attribute__((ext_vector_type(8)));
typedef float f32x4 __attribute__((ext_vector_type(4)));
typedef unsigned u32x4 __attribute__((ext_vector_type(4)));
constexpr int BM = 256, BK = 64, HALF = 128, HTB = HALF * BK * 2, STAGE_BYTES = 8 * HTB, NXCD = 8, WGM = 8;
__host__ __device__ __forceinline__ int lds_byte(int r, int c) { const int st = (r >> 4) * 2 + (c >> 5), rr = r & 15, cc = c & 31, ob = rr * 64 + cc * 2; return st * 1024 + (ob ^ (((ob >> 9) & 1) << 5)); }
__host__ __device__ __forceinline__ void stage_rc(int b, int& R, int& C) { const int st = b / 1024, sb = b % 1024, swz = sb ^ (((sb >> 9) & 1) << 5); R = (st >> 1) * 16 + swz / 64; C = (st & 1) * 32 + (swz % 64) / 2; }
__host__ __device__ __forceinline__ int perm32(int rho) { const int n = rho >> 4, i = rho & 15; return 8 * (i >> 2) + 4 * n + (i & 3); }
struct Unit { int pm, pn; };
struct Gemm { const bf16_t* A; const bf16_t* Bt; int lda, ldb, K, bgt; size_t bgbytes; };
struct StaticOrder {
    int nM, nN, nwg, G, c;
    __host__ __device__ void init(int M_, int N_, int G_, int c_) { nM = M_ / BM; nN = N_ / BM; nwg = nM * nN; G = G_; c = c_; }
    __host__ __device__ bool next(int i, Unit& u) const {
        const long L = (long)i * G + c; if (L >= nwg) return false;
        int wgid = (int)L; { const int q = nwg / NXCD, r = nwg % NXCD, xcd = wgid % NXCD, off = wgid / NXCD; wgid = (xcd < r ? xcd * (q + 1) : r * (q + 1) + (xcd - r) * q) + off; }
        const int nig = WGM * nN, gid = wgid / nig, fm = gid * WGM, gsz = (nM - fm) < WGM ? (nM - fm) : WGM;
        u.pm = fm + ((wgid % nig) % gsz); u.pn = (wgid % nig) / gsz; return true;
    }
    __device__ __forceinline__ void a_ready(const Unit&) const {}
    __device__ __forceinline__ void done(const Unit&) const {}
};
__device__ __forceinline__ unsigned cvt_pk_bf16(float lo, float hi) { return pk2(lo, hi); }

enum EpiMode { EM_SWIGLU = 0, EM_RES, EM_GLU, EM_DKV, EM_UKV, EM_DQ, EM_UQ, EM_SEND, EM_Y };
__device__ __forceinline__ float fast_sigmoid(float x) { return __builtin_amdgcn_rcpf(1.f + __builtin_amdgcn_exp2f(-1.4426950408889634f * x)); }
__device__ __forceinline__ float gelu_tanh_f(float x) {
    const float u = 0.7978845608028654f * (x + 0.044715f * x * x * x);
    return x * fast_sigmoid(2.f * u);
}
struct EpiParams {
    int mode; float inv_k; float alpha; int ldo; int rss_n; int rs_lds;
    const float* rss_in;
    float* rss_out;
    const float* base; float* out;
    bf16_t* ob;
    bf16_t* ob2;
    const float* aux0; const float* aux1;
    const bf16_t* ua;
    float* fout;
};
struct EpiDyn {
    static constexpr bool PERM = true, AFTER_DRAIN = false;
    const PG8_LAS EpiParams* P;
    __device__ __forceinline__ void operator()(const f32x4 (&acc)[2][2][4][2], const Unit& u, int wr, int wc, int fr, int fq) const {
        const int mode = P->mode; const float inv_k = P->inv_k, alpha = P->alpha; const int ldo = P->ldo, rss_n = P->rss_n, rs_lds = P->rs_lds;
#define PG8_G(T, x) ((T*)(__attribute__((address_space(1))) T*)(unsigned long long)(x))
        const float* rss_in = PG8_G(const float, P->rss_in); float* rss_out = PG8_G(float, P->rss_out); const float* base = PG8_G(const float, P->base); float* out = PG8_G(float, P->out);
        bf16_t* ob = PG8_G(bf16_t, P->ob); bf16_t* ob2 = PG8_G(bf16_t, P->ob2);
        const float* aux0 = PG8_G(const float, P->aux0); const float* aux1 = PG8_G(const float, P->aux1); const bf16_t* ua = PG8_G(const bf16_t, P->ua); float* fout = PG8_G(float, P->fout);
#undef PG8_G
#pragma unroll
        for (int ai = 0; ai < 2; ++ai)
#pragma unroll
            for (int m = 0; m < 4; ++m) {
                const int row = u.pm * BM + ai * HALF + wr * 64 + m * 16 + fr;
                float rs = 1.f;
                if (rs_lds) rs = ((const PG8_LAS float*)((const PG8_LAS char*)P + rs_lds))[row & 2047];
                else if (rss_in) {
                    float sq;
                    if (rss_n == 1) sq = gld4f(rss_in, rss_in + row);
                    else { const float* q = rss_in + (size_t)row * rss_n + fq * (rss_n >> 2);
                        if (rss_n == 4) sq = gld4f(rss_in, q);
                        else if (rss_n == 16) { const f32x4 v = gld16f(rss_in, q); sq = (v[0] + v[1]) + (v[2] + v[3]); }
                        else { const f32x4 v = gld16f(rss_in, q), w = gld16f(rss_in, q + 4); sq = ((v[0] + v[1]) + (v[2] + v[3])) + ((w[0] + w[1]) + (w[2] + w[3])); }
                        sq += __shfl_xor(sq, 16); sq += __shfl_xor(sq, 32); }
                    rs = __builtin_amdgcn_rsqf(sq * inv_k + 1e-6f);
                }
                const f32x4 a00 = acc[ai][0][m][0] * rs, a01 = acc[ai][0][m][1] * rs, a10 = acc[ai][1][m][0] * rs, a11 = acc[ai][1][m][1] * rs;
                const int cw = wc * 32 + 8 * fq;
                switch (mode) {
                case EM_SWIGLU: {
                    f32x4 v0, v1;
#pragma unroll
                    for (int i = 0; i < 4; ++i) { v0[i] = a00[i] * fast_sigmoid(a00[i]) * a10[i]; v1[i] = a01[i] * fast_sigmoid(a01[i]) * a11[i]; }
                    u32x4 w; w.x = cvt_pk_bf16(v0[0], v0[1]); w.y = cvt_pk_bf16(v0[2], v0[3]); w.z = cvt_pk_bf16(v1[0], v1[1]); w.w = cvt_pk_bf16(v1[2], v1[3]);
                    gst16(ob, ob + (size_t)row * ldo + u.pn * 128 + cw, w);
                } break;
                case EM_RES: {
                    float ss = 0.f;
#pragma unroll
                    for (int bj = 0; bj < 2; ++bj) {
                        const size_t off = (size_t)row * 1024 + u.pn * 256 + bj * 128 + cw;
                        const f32x4 b0 = gld16f(base, base + off), b1 = gld16f(base, base + off + 4);
                        const f32x4 v0 = b0 + alpha * (bj ? a10 : a00), v1 = b1 + alpha * (bj ? a11 : a01);
                        gst16f(out, out + off, v0); gst16f(out, out + off + 4, v1);
                        u32x4 w; w.x = cvt_pk_bf16(v0[0], v0[1]); w.y = cvt_pk_bf16(v0[2], v0[3]); w.z = cvt_pk_bf16(v1[0], v1[1]); w.w = cvt_pk_bf16(v1[2], v1[3]);
                        gst16(ob, ob + off, w);
                        ss += (v0[0] * v0[0] + v0[1] * v0[1]) + (v0[2] * v0[2] + v0[3] * v0[3]) + (v1[0] * v1[0] + v1[1] * v1[1]) + (v1[2] * v1[2] + v1[3] * v1[3]);
                    }
                    ss += __shfl_xor(ss, 16); ss += __shfl_xor(ss, 32);
                    if (fq == 0) gst4f(rss_out, rss_out + (size_t)row * 16 + u.pn * 4 + wc, ss);
                } break;
                case EM_GLU: {
                    const size_t off = (size_t)row * 1024 + u.pn * 128 + cw;
                    const f32x4 b0 = gld16f(base, base + off), b1 = gld16f(base, base + off + 4);
                    f32x4 v0, v1;
#pragma unroll
                    for (int i = 0; i < 4; ++i) { v0[i] = b0[i] + a00[i] * fast_sigmoid(a10[i]); v1[i] = b1[i] + a01[i] * fast_sigmoid(a11[i]); }
                    gst16f(out, out + off, v0); gst16f(out, out + off + 4, v1);
                    u32x4 w; w.x = cvt_pk_bf16(v0[0], v0[1]); w.y = cvt_pk_bf16(v0[2], v0[3]); w.z = cvt_pk_bf16(v1[0], v1[1]); w.w = cvt_pk_bf16(v1[2], v1[3]);
                    gst16(ob, ob + off, w);
                    float ss = (v0[0] * v0[0] + v0[1] * v0[1]) + (v0[2] * v0[2] + v0[3] * v0[3]) + (v1[0] * v1[0] + v1[1] * v1[1]) + (v1[2] * v1[2] + v1[3] * v1[3]);
                    ss += __shfl_xor(ss, 16); ss += __shfl_xor(ss, 32);
                    if (fq == 0) gst4f(rss_out, rss_out + (size_t)row * 32 + u.pn * 4 + wc, ss);
                } break;
                case EM_DKV: {
                    if (wc < 2) {
                        u32x4 w0, w1;
                        w0.x = cvt_pk_bf16(a00[0], a00[1]); w0.y = cvt_pk_bf16(a00[2], a00[3]); w0.z = cvt_pk_bf16(a01[0], a01[1]); w0.w = cvt_pk_bf16(a01[2], a01[3]);
                        w1.x = cvt_pk_bf16(a10[0], a10[1]); w1.y = cvt_pk_bf16(a10[2], a10[3]); w1.z = cvt_pk_bf16(a11[0], a11[1]); w1.w = cvt_pk_bf16(a11[2], a11[3]);
                        gst16(ob, ob + (size_t)row * P256 + cw, w0); gst16(ob, ob + (size_t)row * P256 + 64 + cw, w1);
                        float ss = 0.f;
#pragma unroll
                        for (int i = 0; i < 4; ++i) ss += a00[i] * a00[i] + a01[i] * a01[i] + a10[i] * a10[i] + a11[i] * a11[i];
                        ss += __shfl_xor(ss, 16); ss += __shfl_xor(ss, 32);
                        if (fq == 0) gst4f(rss_out, rss_out + (size_t)row * 4 + wc, ss);
                    } else if (wc == 2) {
                        if (fq == 0) { gst4f(rss_out, rss_out + (size_t)row * 4 + 2, 0.f); gst4f(rss_out, rss_out + (size_t)row * 4 + 3, 0.f); }
                        const int j0 = 8 * fq;
                        const f32x4 c0 = gld16f(aux0, aux0 + (size_t)row * 32 + j0), c1 = gld16f(aux0, aux0 + (size_t)row * 32 + j0 + 4);
                        const f32x4 s0 = gld16f(aux1, aux1 + (size_t)row * 32 + j0), s1 = gld16f(aux1, aux1 + (size_t)row * 32 + j0 + 4);
                        const f32x4 o10 = a00 * c0 - a10 * s0, o11 = a01 * c1 - a11 * s1, o20 = a00 * s0 + a10 * c0, o21 = a01 * s1 + a11 * c1;
                        u32x4 w0, w1;
                        w0.x = cvt_pk_bf16(o10[0], o10[1]); w0.y = cvt_pk_bf16(o10[2], o10[3]); w0.z = cvt_pk_bf16(o11[0], o11[1]); w0.w = cvt_pk_bf16(o11[2], o11[3]);
                        w1.x = cvt_pk_bf16(o20[0], o20[1]); w1.y = cvt_pk_bf16(o20[2], o20[3]); w1.z = cvt_pk_bf16(o21[0], o21[1]); w1.w = cvt_pk_bf16(o21[2], o21[3]);
                        gst16(ob2, ob2 + (size_t)row * 64 + j0, w0); gst16(ob2, ob2 + (size_t)row * 64 + 32 + j0, w1);
                    }
                } break;
                case EM_UKV: {
                    u32x4 w0, w1;
                    w0.x = cvt_pk_bf16(a00[0], a00[1]); w0.y = cvt_pk_bf16(a00[2], a00[3]); w0.z = cvt_pk_bf16(a01[0], a01[1]); w0.w = cvt_pk_bf16(a01[2], a01[3]);
                    w1.x = cvt_pk_bf16(a10[0], a10[1]); w1.y = cvt_pk_bf16(a10[2], a10[3]); w1.z = cvt_pk_bf16(a11[0], a11[1]); w1.w = cvt_pk_bf16(a11[2], a11[3]);
                    gst16(ob, ob + (size_t)row * 1024 + u.pn * 128 + cw, w0); gst16(ob2, ob2 + (size_t)row * 1024 + u.pn * 128 + cw, w1);
                } break;
                case EM_DQ: {
                    u32x4 w0, w1;
                    w0.x = cvt_pk_bf16(a00[0], a00[1]); w0.y = cvt_pk_bf16(a00[2], a00[3]); w0.z = cvt_pk_bf16(a01[0], a01[1]); w0.w = cvt_pk_bf16(a01[2], a01[3]);
                    w1.x = cvt_pk_bf16(a10[0], a10[1]); w1.y = cvt_pk_bf16(a10[2], a10[3]); w1.z = cvt_pk_bf16(a11[0], a11[1]); w1.w = cvt_pk_bf16(a11[2], a11[3]);
                    gst16(ob, ob + (size_t)row * P256 + cw, w0); gst16(ob, ob + (size_t)row * P256 + 128 + cw, w1);
                    float ss = 0.f;
#pragma unroll
                    for (int i = 0; i < 4; ++i) ss += a00[i] * a00[i] + a01[i] * a01[i] + a10[i] * a10[i] + a11[i] * a11[i];
                    ss += __shfl_xor(ss, 16); ss += __shfl_xor(ss, 32);
                    if (fq == 0) gst4f(rss_out, rss_out + (size_t)row * 4 + wc, ss);
                } break;
                case EM_UQ: {
                    const float qs = alpha;
                    if (u.pn < 4) {
                        u32x4 w0, w1;
                        w0.x = cvt_pk_bf16(a00[0] * qs, a00[1] * qs); w0.y = cvt_pk_bf16(a00[2] * qs, a00[3] * qs); w0.z = cvt_pk_bf16(a01[0] * qs, a01[1] * qs); w0.w = cvt_pk_bf16(a01[2] * qs, a01[3] * qs);
                        w1.x = cvt_pk_bf16(a10[0] * qs, a10[1] * qs); w1.y = cvt_pk_bf16(a10[2] * qs, a10[3] * qs); w1.z = cvt_pk_bf16(a11[0] * qs, a11[1] * qs); w1.w = cvt_pk_bf16(a11[2] * qs, a11[3] * qs);
                        gst16(ob, ob + (size_t)row * 1536 + (2 * u.pn) * 192 + cw, w0); gst16(ob, ob + (size_t)row * 1536 + (2 * u.pn + 1) * 192 + cw, w1);
                    } else {
                        const int head = 4 * (u.pn - 4) + wc, j0 = 8 * fq;
                        const f32x4 c0 = gld16f(aux0, aux0 + (size_t)row * 32 + j0) * qs, c1 = gld16f(aux0, aux0 + (size_t)row * 32 + j0 + 4) * qs;
                        const f32x4 s0 = gld16f(aux1, aux1 + (size_t)row * 32 + j0) * qs, s1 = gld16f(aux1, aux1 + (size_t)row * 32 + j0 + 4) * qs;
                        const f32x4 o10 = a00 * c0 - a10 * s0, o11 = a01 * c1 - a11 * s1, o20 = a00 * s0 + a10 * c0, o21 = a01 * s1 + a11 * c1;
                        u32x4 w0, w1;
                        w0.x = cvt_pk_bf16(o10[0], o10[1]); w0.y = cvt_pk_bf16(o10[2], o10[3]); w0.z = cvt_pk_bf16(o11[0], o11[1]); w0.w = cvt_pk_bf16(o11[2], o11[3]);
                        w1.x = cvt_pk_bf16(o20[0], o20[1]); w1.y = cvt_pk_bf16(o20[2], o20[3]); w1.z = cvt_pk_bf16(o21[0], o21[1]); w1.w = cvt_pk_bf16(o21[2], o21[3]);
                        bf16_t* qp = ob + (size_t)row * 1536 + head * 192 + 128 + j0;
                        gst16(ob, qp, w0); gst16(ob, qp + 32, w1);
                    }
                } break;
                case EM_SEND: {
                    float* p = fout + (size_t)row * 128 + cw;
                    gst16f(fout, p, a00); gst16f(fout, p + 4, a01);
                } break;
                case EM_Y: {
                    const int g = row >> 10, n = row & 1023;
#pragma unroll
                    for (int bj = 0; bj < 2; ++bj) {
                        const int c = bj * 128 + cw, tt = c >> 4, o0 = c & 15;
                        const u32x4 uu = gld16(ua, ua + (size_t)row * 384 + c);
                        const f32x4 d0 = *(const f32x4*)(aux0 + g * 16 + o0), d1 = *(const f32x4*)(aux0 + g * 16 + o0 + 4);
                        const f32x4 y0 = bj ? a10 : a00, y1 = bj ? a11 : a01;
                        float v[8];
                        { const h16x8 uh = __builtin_bit_cast(h16x8, uu);
                          v[0] = y0[0] + d0[0] * (float)uh[0]; v[1] = y0[1] + d0[1] * (float)uh[1]; v[2] = y0[2] + d0[2] * (float)uh[2]; v[3] = y0[3] + d0[3] * (float)uh[3];
                          v[4] = y1[0] + d1[0] * (float)uh[4]; v[5] = y1[1] + d1[1] * (float)uh[5]; v[6] = y1[2] + d1[2] * (float)uh[6]; v[7] = y1[3] + d1[3] * (float)uh[7]; }
#pragma unroll
                        for (int i = 0; i < 8; ++i) v[i] = gelu_tanh_f(v[i]);
                        u32x4 w; w.x = cvt_pk_bf16(v[0], v[1]); w.y = cvt_pk_bf16(v[2], v[3]); w.z = cvt_pk_bf16(v[4], v[5]); w.w = cvt_pk_bf16(v[6], v[7]);
                        gst16(ob, ob + (size_t)(16 * n + tt) * 1024 + g * 16 + o0, w);
                    }
                } break;
                default: break;
                }
            }
    }
};

template <class Epi, class Sched, bool ALIGN_EPI = false, bool SP2 = false>
__device__ __forceinline__ void gemm_phase(PG8_LAS unsigned char* lds, const Gemm g, const Sched& S, const Epi& E, int tid_in) {
    const int tid = tid_in, wid = __builtin_amdgcn_readfirstlane(tid >> 6), lane = tid & 63, wr = wid >> 2, wc = wid & 3, fr = lane & 15, fq = lane >> 4;
    const int K = g.K, nt = K / BK;
    unsigned voffA[2], voffB[2];
#pragma unroll
    for (int i = 0; i < 2; ++i) { int R, C; stage_rc(tid * 16 + i * 8192, R, C); const int Rb = Epi::PERM ? ((R & ~31) + perm32(R & 31)) : R;
        voffA[i] = (unsigned)(R * g.lda + C) * 2u; voffB[i] = (unsigned)(Rb * g.ldb + C) * 2u; }
    const size_t kstep = (size_t)(BK * 2);
    const size_t hstepA = (size_t)HALF * g.lda * 2, hstepB = (size_t)HALF * g.ldb * 2;
    const size_t tstepA = 2 * hstepA, tstepB = 2 * hstepB;
    const unsigned ldsw = (unsigned)wid * 1024u;
    const int aoff = lds_byte(wr * 64 + fr, fq * 8), boff = lds_byte(wc * 32 + fr, fq * 8);
#define PG8_SA(b, h) (((b) * 2 + (h)) * HTB)
#define PG8_SB(b, h) ((4 + (b) * 2 + (h)) * HTB)
#define PG8_STAGE(bufoff, gbase, voff) do { _Pragma("unroll") for (int _i = 0; _i < 2; ++_i) \
        __builtin_amdgcn_global_load_lds((const unsigned*)((const char*)(gbase) + (voff)[_i]), (PG8_LAS unsigned*)(lds + (bufoff) + ldsw + _i * 8192), 16, 0, PG8_AUX); } while (0)
#define PG8_LDA(dst, b, h) do { _Pragma("unroll") for (int m = 0; m < 4; ++m) _Pragma("unroll") for (int k = 0; k < 2; ++k) dst[m][k] = *(const PG8_LAS bf16x8*)(lds + PG8_SA(b, h) + aoff + m * 2048 + k * 1024); } while (0)
#define PG8_LDB(dst, b, h) do { _Pragma("unroll") for (int n = 0; n < 2; ++n) _Pragma("unroll") for (int k = 0; k < 2; ++k) dst[n][k] = *(const PG8_LAS bf16x8*)(lds + PG8_SB(b, h) + boff + n * 2048 + k * 1024); } while (0)
#define PG8_MMA(ai, bj, At, Bt) do { __builtin_amdgcn_s_setprio(1); _Pragma("unroll") for (int m = 0; m < 4; ++m) _Pragma("unroll") for (int n = 0; n < 2; ++n) _Pragma("unroll") for (int k = 0; k < 2; ++k) \
        acc[ai][bj][m][n] = __builtin_amdgcn_mfma_f32_16x16x32_f16(__builtin_bit_cast(h16x8, Bt[n][k]), __builtin_bit_cast(h16x8, At[m][k]), acc[ai][bj][m][n], 0, 0, 0); __builtin_amdgcn_s_setprio(0); } while (0)
#define PG8_WAIT_V(n) asm volatile("s_waitcnt vmcnt(" #n ")" ::: "memory")
#define PG8_WAIT_L(n) asm volatile("s_waitcnt lgkmcnt(" #n ")" ::: "memory")
#define PG8_BAR __builtin_amdgcn_s_barrier()
#define PG8_SCHED __builtin_amdgcn_sched_barrier(0)
    Unit cur, nxt; int ui = 0;
    if (!S.next(0, cur)) return;
    f32x4 acc[2][2][4][2];
#pragma unroll
    for (int a = 0; a < 2; ++a)
#pragma unroll
        for (int b = 0; b < 2; ++b)
#pragma unroll
            for (int m = 0; m < 4; ++m)
#pragma unroll
                for (int n = 0; n < 2; ++n) acc[a][b][m][n] = (f32x4){0.f, 0.f, 0.f, 0.f};
    bf16x8 At[4][2], B0[2][2], B1[2][2];
    const char* cA = (const char*)g.A + (size_t)cur.pm * tstepA; const char* cB = (const char*)g.Bt + (size_t)(cur.pm / g.bgt) * g.bgbytes + (size_t)cur.pn * tstepB;
    S.a_ready(cur);
    if constexpr (SP2) {
        PG8_STAGE(PG8_SB(0, 0), cB, voffB); PG8_STAGE(PG8_SB(0, 1), cB + hstepB, voffB); PG8_STAGE(PG8_SA(0, 0), cA, voffA); PG8_STAGE(PG8_SA(0, 1), cA + hstepA, voffA);
        if (wr == 1) PG8_BAR;
        PG8_WAIT_V(2); PG8_BAR;
        PG8_STAGE(PG8_SB(1, 0), cB + kstep, voffB); PG8_STAGE(PG8_SA(1, 0), cA + kstep, voffA); PG8_STAGE(PG8_SB(1, 1), cB + hstepB + kstep, voffB);
        PG8_WAIT_V(6); PG8_BAR;
    } else {
        PG8_STAGE(PG8_SB(0, 0), cB, voffB); PG8_STAGE(PG8_SA(0, 0), cA, voffA); PG8_STAGE(PG8_SB(0, 1), cB + hstepB, voffB); PG8_STAGE(PG8_SA(0, 1), cA + hstepA, voffA);
        if (wr == 1) PG8_BAR;
        PG8_WAIT_V(4); PG8_BAR;
        PG8_STAGE(PG8_SB(1, 0), cB + kstep, voffB); PG8_STAGE(PG8_SA(1, 0), cA + kstep, voffA); PG8_STAGE(PG8_SB(1, 1), cB + hstepB + kstep, voffB);
        PG8_WAIT_V(6); PG8_BAR;
    }
    for (;;) {
        const bool has_next = S.next(ui + 1, nxt);
        const char* nA = has_next ? (const char*)g.A + (size_t)nxt.pm * tstepA : cA; const char* nB = has_next ? (const char*)g.Bt + (size_t)(nxt.pm / g.bgt) * g.bgbytes + (size_t)nxt.pn * tstepB : cB;
        for (int t = 0; t < nt; t += 2) {
            const bool last = (t == nt - 2);
            const char* a1 = cA + (size_t)(t + 1) * kstep;
            const char* a2 = last ? nA : cA + (size_t)(t + 2) * kstep; const char* b2 = last ? nB : cB + (size_t)(t + 2) * kstep;
            const char* a3 = a2 + kstep; const char* b3 = b2 + kstep;
            if (last && has_next) S.a_ready(nxt);
            if constexpr (SP2) {
            PG8_LDB(B0, 0, 0); PG8_LDB(B1, 0, 1); PG8_SCHED; PG8_LDA(At, 0, 0); PG8_STAGE(PG8_SA(1, 1), a1 + hstepA, voffA);
            PG8_WAIT_V(8); PG8_WAIT_L(0); PG8_BAR; PG8_MMA(0, 0, At, B0); PG8_MMA(0, 1, At, B1); PG8_BAR; PG8_SCHED;
            PG8_LDA(At, 0, 1); PG8_STAGE(PG8_SB(0, 0), b2, voffB); PG8_STAGE(PG8_SB(0, 1), b2 + hstepB, voffB); PG8_STAGE(PG8_SA(0, 0), a2, voffA);
            PG8_WAIT_V(8); PG8_WAIT_L(0); PG8_BAR; PG8_MMA(1, 0, At, B0); PG8_MMA(1, 1, At, B1); PG8_BAR; PG8_SCHED;
            PG8_LDB(B0, 1, 0); PG8_LDB(B1, 1, 1); PG8_SCHED; PG8_LDA(At, 1, 0); PG8_STAGE(PG8_SA(0, 1), a2 + hstepA, voffA);
            PG8_WAIT_V(8); PG8_WAIT_L(0); PG8_BAR; PG8_MMA(0, 0, At, B0); PG8_MMA(0, 1, At, B1); PG8_BAR; PG8_SCHED;
            PG8_LDA(At, 1, 1); PG8_STAGE(PG8_SB(1, 0), b3, voffB); PG8_STAGE(PG8_SB(1, 1), b3 + hstepB, voffB); PG8_STAGE(PG8_SA(1, 0), a3, voffA);
            PG8_WAIT_V(8); PG8_WAIT_L(0); PG8_BAR; PG8_MMA(1, 0, At, B0); PG8_MMA(1, 1, At, B1); PG8_BAR; PG8_SCHED;
            } else {
            PG8_LDB(B0, 0, 0); PG8_SCHED; PG8_LDA(At, 0, 0); PG8_STAGE(PG8_SA(1, 1), a1 + hstepA, voffA);
            PG8_WAIT_L(8); PG8_BAR; PG8_WAIT_L(0); PG8_MMA(0, 0, At, B0); PG8_BAR; PG8_SCHED;
            PG8_LDB(B1, 0, 1); PG8_STAGE(PG8_SB(0, 0), b2, voffB);
            PG8_BAR; PG8_WAIT_L(0); PG8_MMA(0, 1, At, B1); PG8_BAR;
            PG8_LDA(At, 0, 1); PG8_STAGE(PG8_SA(0, 0), a2, voffA);
            PG8_BAR; PG8_WAIT_L(0); PG8_MMA(1, 0, At, B0); PG8_BAR; PG8_SCHED;
            PG8_STAGE(PG8_SB(0, 1), b2 + hstepB, voffB);
            PG8_WAIT_V(6); PG8_BAR; PG8_MMA(1, 1, At, B1); PG8_BAR;
            PG8_LDB(B0, 1, 0); PG8_SCHED; PG8_LDA(At, 1, 0); PG8_STAGE(PG8_SA(0, 1), a2 + hstepA, voffA);
            PG8_WAIT_L(8); PG8_BAR; PG8_WAIT_L(0); PG8_MMA(0, 0, At, B0); PG8_BAR; PG8_SCHED;
            PG8_LDB(B1, 1, 1); PG8_STAGE(PG8_SB(1, 0), b3, voffB);
            PG8_BAR; PG8_WAIT_L(0); PG8_MMA(0, 1, At, B1); PG8_BAR;
            PG8_LDA(At, 1, 1); PG8_STAGE(PG8_SA(1, 0), a3, voffA);
            PG8_BAR; PG8_WAIT_L(0); PG8_MMA(1, 0, At, B0); PG8_BAR; PG8_SCHED;
            PG8_STAGE(PG8_SB(1, 1), b3 + hstepB, voffB);
            PG8_WAIT_V(6); PG8_BAR; PG8_MMA(1, 1, At, B1); PG8_BAR;
            }
        }
        if constexpr (ALIGN_EPI) { if (wr == 0) PG8_BAR; }
        if constexpr (!Epi::AFTER_DRAIN) { E(acc, cur, wr, wc, fr, fq); S.done(cur); }
        if (!has_next) break;
#pragma unroll
        for (int a = 0; a < 2; ++a)
#pragma unroll
            for (int b = 0; b < 2; ++b)
#pragma unroll
                for (int m = 0; m < 4; ++m)
#pragma unroll
                    for (int n = 0; n < 2; ++n) acc[a][b][m][n] = (f32x4){0.f, 0.f, 0.f, 0.f};
        cur = nxt; cA = nA; cB = nB; ++ui;
        if constexpr (ALIGN_EPI) { if (wr == 1) PG8_BAR; }
    }
    PG8_WAIT_V(0);
    if constexpr (!ALIGN_EPI) { if (wr == 0) PG8_BAR; }
    PG8_BAR;
    if constexpr (Epi::AFTER_DRAIN) { E.fused(acc, cur, wr, wc, fr, fq, lds, wid, lane); S.done(cur); }
#undef PG8_SA
#undef PG8_SB
#undef PG8_STAGE
#undef PG8_LDA
#undef PG8_LDB
#undef PG8_MMA
#undef PG8_WAIT_V
#undef PG8_WAIT_L
#undef PG8_BAR
#undef PG8_SCHED
}

}

namespace attn {
typedef unsigned short bf16_t;
using bf16x8 = __attribute__((ext_vector_type(8))) short;
using s16x4 = __attribute__((ext_vector_type(4))) short;
using f32x16 = __attribute__((ext_vector_type(16))) float;
using u32x4 = __attribute__((ext_vector_type(4))) unsigned;
constexpr int NW = 8, QBLK = 32, KVBLK = 64;
constexpr int SHM_V = KVBLK * 128 * 2, SHM_K = KVBLK * 192 * 2, SHM_ATTN = 2 * SHM_V + 2 * SHM_K + NW * 64 * 4;
constexpr float THR = 8.f;
#ifndef ATTN_SDEPTH
#define ATTN_SDEPTH 2
#endif
constexpr int SDEPTH = ATTN_SDEPTH;
#define KSWZ(row, colB) ((row) * 384 + ((colB) ^ ((((row) >> 1) & 7) << 4)))
#define SBAR() __builtin_amdgcn_sched_barrier(0)
__device__ __forceinline__ int crow(int r, int hi) { return (r & 3) + 8 * (r >> 2) + 4 * hi; }
__device__ __forceinline__ unsigned cvtpk(float lo, float hi) { return pk2(lo, hi); }

__device__ __forceinline__ void partialSM(f32x16& p0, f32x16& p1, float& m_reg, float& mn, float& alpha) {
  float pmax = p0[0];
#pragma unroll
  for (int r = 1; r < 16; ++r) pmax = fmaxf(pmax, p0[r]);
#pragma unroll
  for (int r = 0; r < 16; ++r) pmax = fmaxf(pmax, p1[r]);
  { auto rr = __builtin_amdgcn_permlane32_swap(__float_as_uint(pmax), __float_as_uint(pmax), false, false);
    pmax = fmaxf(__uint_as_float(rr[0]), __uint_as_float(rr[1])); }
  if (__builtin_expect(__all(pmax - m_reg <= THR), 1)) { mn = m_reg; alpha = 1.f; }
  else { mn = fmaxf(m_reg, pmax); alpha = __builtin_amdgcn_exp2f(m_reg - mn); m_reg = mn; }
#pragma unroll
  for (int r = 0; r < 16; ++r) p0[r] = p0[r] - mn;
#pragma unroll
  for (int r = 0; r < 16; ++r) p1[r] = p1[r] - mn;
#pragma unroll
  for (int r = 0; r < 16; ++r) p0[r] = __builtin_amdgcn_exp2f(p0[r]);
}
__device__ __forceinline__ void finishSM(f32x16& p0, f32x16& p1, float alpha, float& l_reg, bf16x8& pa0, bf16x8& pa1, bf16x8& pa2, bf16x8& pa3) {
#pragma unroll
  for (int r = 0; r < 16; ++r) p1[r] = __builtin_amdgcn_exp2f(p1[r]);
  float ps = 0;
#pragma unroll
  for (int r = 0; r < 16; ++r) ps += p0[r];
#pragma unroll
  for (int r = 0; r < 16; ++r) ps += p1[r];
  { auto rr = __builtin_amdgcn_permlane32_swap(__float_as_uint(ps), __float_as_uint(ps), false, false);
    ps = __uint_as_float(rr[0]) + __uint_as_float(rr[1]); }
  l_reg = l_reg * alpha + ps;
#define PK4(P, BASE, OUT) do { unsigned a0 = cvtpk(P[BASE + 0], P[BASE + 1]), a1 = cvtpk(P[BASE + 2], P[BASE + 3]);   \
    unsigned b0 = cvtpk(P[BASE + 4], P[BASE + 5]), b1 = cvtpk(P[BASE + 6], P[BASE + 7]);                              \
    auto r0 = __builtin_amdgcn_permlane32_swap(a0, b0, false, false); auto r1 = __builtin_amdgcn_permlane32_swap(a1, b1, false, false); \
    u32x4 w = {r0[0], r1[0], r0[1], r1[1]}; OUT = *reinterpret_cast<bf16x8*>(&w); } while (0)
  PK4(p0, 0, pa0); PK4(p0, 8, pa1); PK4(p1, 0, pa2); PK4(p1, 8, pa3);
#undef PK4
}
__device__ __forceinline__ void qkt(f32x16& p0, f32x16& p1, const char* Ks, const bf16x8* qr, int r32, int hi) {
  p0 = f32x16{}; p1 = f32x16{};
#pragma unroll
  for (int d0 = 0; d0 < 12; ++d0) { const int cb = (d0 * 16 + hi * 8) * 2;
    const bf16x8 b0 = *reinterpret_cast<const bf16x8*>(Ks + KSWZ(r32, cb));
    const bf16x8 b1 = *reinterpret_cast<const bf16x8*>(Ks + KSWZ(32 + r32, cb));
    p0 = __builtin_amdgcn_mfma_f32_32x32x16_f16(__builtin_bit_cast(h16x8, b0), __builtin_bit_cast(h16x8, qr[d0]), p0, 0, 0, 0);
    p1 = __builtin_amdgcn_mfma_f32_32x32x16_f16(__builtin_bit_cast(h16x8, b1), __builtin_bit_cast(h16x8, qr[d0]), p1, 0, 0, 0); }
}
__device__ __forceinline__ int v_st(int k, int c) { const int kk = (k & ~0xC) | ((k & 4) << 1) | ((k & 8) >> 1); return ((kk >> 3) * 4 + (c >> 5)) * 512 + ((kk & 7) * 32 + (c & 31)) * 2; }
__device__ __forceinline__ int v_rd_base(int lane) { return ((lane & 3) << 3) | (((lane >> 2) & 3) << 6) | (((lane >> 4) & 1) << 5) | (((lane >> 5) & 1) << 8); }
constexpr int v_rd_off(int d0, int ks, int half) { return d0 * 512 + ks * 4096 + half * 2048; }
template <int OFF> __device__ __forceinline__ s16x4 tr_read(int vb) {
  s16x4 r; asm volatile("ds_read_b64_tr_b16 %0, %1 offset:%2" : "=&v"(r) : "v"(vb), "i"(OFF) : "memory"); return r;
}
template <int D0> __device__ __forceinline__ void pv_one(f32x16& od, int vb, bf16x8 pa0, bf16x8 pa1, bf16x8 pa2, bf16x8 pa3) {
  const s16x4 l0 = tr_read<v_rd_off(D0, 0, 0)>(vb), h0 = tr_read<v_rd_off(D0, 0, 1)>(vb), l1 = tr_read<v_rd_off(D0, 1, 0)>(vb), h1 = tr_read<v_rd_off(D0, 1, 1)>(vb);
  const s16x4 l2 = tr_read<v_rd_off(D0, 2, 0)>(vb), h2 = tr_read<v_rd_off(D0, 2, 1)>(vb), l3 = tr_read<v_rd_off(D0, 3, 0)>(vb), h3 = tr_read<v_rd_off(D0, 3, 1)>(vb);
  asm volatile("s_waitcnt lgkmcnt(0)" ::: "memory"); SBAR();
#define PK(L, H) (bf16x8){L[0], L[1], L[2], L[3], H[0], H[1], H[2], H[3]}
  od = __builtin_amdgcn_mfma_f32_32x32x16_f16(__builtin_bit_cast(h16x8, pa0), __builtin_bit_cast(h16x8, PK(l0, h0)), od, 0, 0, 0);
  od = __builtin_amdgcn_mfma_f32_32x32x16_f16(__builtin_bit_cast(h16x8, pa1), __builtin_bit_cast(h16x8, PK(l1, h1)), od, 0, 0, 0);
  od = __builtin_amdgcn_mfma_f32_32x32x16_f16(__builtin_bit_cast(h16x8, pa2), __builtin_bit_cast(h16x8, PK(l2, h2)), od, 0, 0, 0);
  od = __builtin_amdgcn_mfma_f32_32x32x16_f16(__builtin_bit_cast(h16x8, pa3), __builtin_bit_cast(h16x8, PK(l3, h3)), od, 0, 0, 0);
#undef PK
}
__device__ __forceinline__ void pv_d0(f32x16* o, int vb, bf16x8 pa0, bf16x8 pa1, bf16x8 pa2, bf16x8 pa3) {
  pv_one<0>(o[0], vb, pa0, pa1, pa2, pa3); pv_one<1>(o[1], vb, pa0, pa1, pa2, pa3); pv_one<2>(o[2], vb, pa0, pa1, pa2, pa3); pv_one<3>(o[3], vb, pa0, pa1, pa2, pa3);
}

__device__ __forceinline__ void attn_unit(const bf16_t* __restrict__ Qu, const bf16_t* __restrict__ Knh, const bf16_t* __restrict__ Krb, const bf16_t* __restrict__ Vh,
                                          bf16_t* __restrict__ Ou, int NT, int qb4, char* lds, int tid_in) {
  const int tid = tid_in, wid = __builtin_amdgcn_readfirstlane(tid >> 6), lane = tid & 63, r32 = lane & 31, hi = lane >> 5;
  const int lim = qb4 + (wid >> 1);
  char* V_lds = lds; char* K_lds = lds + 2 * SHM_V;
  float* ws = (float*)(lds + 2 * SHM_V + 2 * SHM_K) + wid * 64; float* li_l = ws; float* al_l = ws + 32;
  float m_reg = -1e30f, l_reg = 0; f32x16 o[4] = {}; bf16x8 qr[12];
  const bf16_t* Qw = Qu + (long)(wid * QBLK + r32) * 1536 + hi * 8;
#pragma unroll
  for (int d0 = 0; d0 < 12; ++d0) qr[d0] = __builtin_bit_cast(bf16x8, gld16(Qu, Qw + d0 * 16));
  const int kr0 = tid >> 4, kch = tid & 15, rr0 = tid >> 3, rch = tid & 7, vsc = (tid & 15) * 8;
  const int kst0 = KSWZ(kr0, kch * 16), kst1 = KSWZ(32 + kr0, kch * 16), kst2 = KSWZ(rr0, 256 + rch * 16), vst0 = v_st(kr0, vsc), vst1 = v_st(32 + kr0, vsc);
  const int vb0 = (int)(uintptr_t)V_lds + v_rd_base(lane);
  bf16x8 sk0, sk1, sk2, sv0, sv1;
#define LD8B(base, p) (__builtin_bit_cast(bf16x8, gld16((base), (p))))
#define SLOAD(key0) do { sv0 = LD8B(Vh, Vh + (long)((key0) + kr0) * 1024 + vsc); sv1 = LD8B(Vh, Vh + (long)((key0) + 32 + kr0) * 1024 + vsc); \
    sk0 = LD8B(Knh, Knh + (long)((key0) + kr0) * 1024 + kch * 8); sk1 = LD8B(Knh, Knh + (long)((key0) + 32 + kr0) * 1024 + kch * 8); \
    sk2 = LD8B(Krb, Krb + (long)((key0) + rr0) * 64 + rch * 8); } while (0)
#define SWRITE(b) do { *(bf16x8*)(V_lds + (b) * SHM_V + vst0) = sv0; *(bf16x8*)(V_lds + (b) * SHM_V + vst1) = sv1; \
    *(bf16x8*)(K_lds + (b) * SHM_K + kst0) = sk0; *(bf16x8*)(K_lds + (b) * SHM_K + kst1) = sk1; *(bf16x8*)(K_lds + (b) * SHM_K + kst2) = sk2; } while (0)
  SLOAD(0); asm volatile("s_waitcnt vmcnt(0)" ::: "memory"); SWRITE(0); __syncthreads();
  for (int j = 0; j < NT; ++j) {
    const int buf = j & 1;
    if (j + 1 < NT) SLOAD((j + 1) * KVBLK);
    if (j <= lim) {
      f32x16 p0, p1; float mn, alpha; bf16x8 pa0, pa1, pa2, pa3;
      qkt(p0, p1, K_lds + buf * SHM_K, qr, r32, hi);
      partialSM(p0, p1, m_reg, mn, alpha);
      finishSM(p0, p1, alpha, l_reg, pa0, pa1, pa2, pa3);
      if (__any(alpha < 1.f)) { if (hi == 0) al_l[r32] = alpha; asm volatile("s_waitcnt lgkmcnt(0)" ::: "memory");
#pragma unroll
        for (int d = 0; d < 4; ++d)
#pragma unroll
          for (int r = 0; r < 16; ++r) o[d][r] *= al_l[crow(r, hi)]; }
      SBAR();
      pv_d0(o, vb0 + buf * (int)SHM_V, pa0, pa1, pa2, pa3);
    }
    if (j + 1 < NT) { asm volatile("s_waitcnt vmcnt(0)" ::: "memory"); SWRITE(buf ^ 1); }
    __syncthreads();
  }
  if (hi == 0) li_l[r32] = l_reg; asm volatile("s_waitcnt lgkmcnt(0)" ::: "memory");
  float rli[16];
#pragma unroll
  for (int r = 0; r < 16; ++r) rli[r] = __builtin_amdgcn_rcpf(li_l[crow(r, hi)]);
  bf16_t* Ow = Ou + (long)(wid * QBLK) * 1024;
  { bf16_t* stg = (bf16_t*)(lds + wid * 8192);
#pragma unroll
    for (int r = 0; r < 16; ++r) { const int orow = crow(r, hi);
#pragma unroll
      for (int d0 = 0; d0 < 4; ++d0) stg[orow * 128 + d0 * 32 + r32] = (bf16_t)(cvtpk(o[d0][r] * rli[r], 0.f) & 0xffffu); }
    asm volatile("s_waitcnt lgkmcnt(0)" ::: "memory");
#pragma unroll 1
    for (int i = 0; i < 8; ++i) { const int row = i * 4 + (lane >> 4), ch = lane & 15;
      const u32x4 v = *(const u32x4*)(stg + row * 128 + ch * 8);
      gst16(Ou, Ow + (long)row * 1024 + ch * 8, v); } }
  __syncthreads();
#undef LD8B
#undef SLOAD
#undef SWRITE
}
__device__ __forceinline__ void attn_phase(char* lds, const bf16_t* Q, const bf16_t* Kn, const bf16_t* Kr, const bf16_t* V, bf16_t* O, int vcu, int G, int tid_in) {
  for (int v = vcu; v < 256; v += G) {
    const int bh = v >> 2, b = bh >> 3, h = bh & 7, s = v & 3;
#pragma unroll 1
    for (int i = 0; i < 2; ++i) {
      const int qb = i ? 7 - s : s;
      const long row0 = (long)b * 2048 + qb * 256;
      attn_unit(Q + row0 * 1536 + h * 192, Kn + (long)b * 2048 * 1024 + h * 128, Kr + (long)b * 2048 * 64, V + (long)b * 2048 * 1024 + h * 128, O + row0 * 1024 + h * 128, 4 * qb + 4, 4 * qb, lds, tid_in);
    }
  }
}
#undef KSWZ
#undef SBAR
}


#define XB_TMO      128
#define XB_XCNT(j)  (256  + 64 * (j))
#define XB_XSUB(j)  (1280 + 64 * (j))
#define XB_XGEN(j)  (2304 + 64 * (j))
#define XB_TOP      3328
#define XB_TOPGEN   3392
#define XCD_BAR_WORDS 3456
#define XB_SPIN_CAP (1u << 18)

__device__ __forceinline__ unsigned xb_ld(unsigned* p)              { return __hip_atomic_load(p, __ATOMIC_RELAXED, __HIP_MEMORY_SCOPE_AGENT); }
__device__ __forceinline__ unsigned xb_add(unsigned* p, unsigned v) { return __hip_atomic_fetch_add(p, v, __ATOMIC_RELAXED, __HIP_MEMORY_SCOPE_AGENT); }
__device__ __forceinline__ unsigned xb_xcc_id() { return (unsigned)__builtin_amdgcn_s_getreg((3 << 11) | 20) & 0xFu; }
#define XB_SPIN(cond, bar) do { unsigned _sp = 0; while (cond) { __builtin_amdgcn_s_sleep(1); \
    if ((++_sp & 255u) == 0u) { if (xb_ld(&(bar)[XB_TMO])) break; if (_sp > XB_SPIN_CAP) { atomicAdd(&(bar)[XB_TMO], 1u); break; } } } } while (0)

struct XcdBarrier {
    unsigned* bar; unsigned x;
    volatile LAS unsigned* st;
};

__device__ __forceinline__ XcdBarrier xcd_barrier_post(unsigned* bar, volatile LAS unsigned* st) {
    XcdBarrier b; b.bar = bar; b.x = xb_xcc_id(); b.st = st;
    if (threadIdx.x == 0) (void)xb_add(&bar[XB_XCNT(b.x)], 1u);
    return b;
}
__device__ __forceinline__ void xcd_barrier_complete(unsigned* bar, unsigned x, unsigned& nloc, unsigned& nx) {
    const unsigned G = gridDim.x * gridDim.y * gridDim.z;
    unsigned sum, cnt, mine, sp = 0u;
    for (;;) {
        sum = 0u; cnt = 0u; mine = 0u;
#pragma unroll
        for (unsigned j = 0; j < 16; ++j) { const unsigned c = xb_ld(&bar[XB_XCNT(j)]); sum += c; cnt += (c > 0u) ? 1u : 0u; mine = (j == x) ? c : mine; }
        if (sum == G) break;
        __builtin_amdgcn_s_sleep(1);
        if ((++sp & 255u) == 0u) { if (xb_ld(&bar[XB_TMO])) break; if (sp > XB_SPIN_CAP) { atomicAdd(&bar[XB_TMO], 1u); break; } }
    }
    nloc = mine > 0u ? mine : 1u; nx = cnt > 0u ? cnt : 1u;
}

__device__ __forceinline__ void xcd_barrier(const XcdBarrier& b) {
    asm volatile("s_waitcnt vmcnt(0)" ::: "memory");
    __syncthreads();
    if (threadIdx.x == 0) {
        unsigned* bar = b.bar;
        __builtin_amdgcn_s_waitcnt(0);
        unsigned nloc = b.st[0], nx = b.st[1];
        if (nloc == 0u) { xcd_barrier_complete(bar, b.x, nloc, nx); b.st[0] = nloc; b.st[1] = nx; }
        const unsigned old = xb_add(&bar[XB_XSUB(b.x)], 1u);
        const unsigned gen = old / nloc;
        if (old + 1u == (gen + 1u) * nloc) {
            __builtin_amdgcn_fence(__ATOMIC_RELEASE, "agent");
            asm volatile("s_waitcnt vmcnt(0)" ::: "memory");
            const unsigned og = xb_add(&bar[XB_TOP], 1u);
            const unsigned tg = og / nx;
            if (og + 1u == (tg + 1u) * nx) xb_add(&bar[XB_TOPGEN], 1u);
            else XB_SPIN(xb_ld(&bar[XB_TOPGEN]) == tg, bar);
            __builtin_amdgcn_fence(__ATOMIC_ACQUIRE, "agent");
            xb_add(&bar[XB_XGEN(b.x)], 1u);
            asm volatile("s_waitcnt vmcnt(0)" ::: "memory");
        } else {
            XB_SPIN(xb_ld(&bar[XB_XGEN(b.x)]) == gen, bar);
            __builtin_amdgcn_fence(__ATOMIC_ACQUIRE, "agent");
            asm volatile("s_waitcnt vmcnt(0)" ::: "memory");
        }
    }
    __syncthreads();
}


__device__ __forceinline__ void sb_begin(unsigned* ctlw) {
    if (threadIdx.x == 0) {
        unsigned e1 = 0xAAAAAAAAu, e2 = 0xAAAAAAAAu;
        __hip_atomic_compare_exchange_strong(ctlw + CW_BAR + 64, &e1, 0u, __ATOMIC_RELAXED, __ATOMIC_RELAXED, __HIP_MEMORY_SCOPE_AGENT);
        __hip_atomic_compare_exchange_strong(ctlw + CW_BAR + 128, &e2, 0u, __ATOMIC_RELAXED, __ATOMIC_RELAXED, __HIP_MEMORY_SCOPE_AGENT);
    }
}
__device__ __forceinline__ void sb_end(unsigned* ctlw) {
    if (threadIdx.x == 0) {
        const unsigned G = gridDim.x * gridDim.y * gridDim.z;
        if (__hip_atomic_fetch_add(ctlw + CW_BAR + 128, 1u, __ATOMIC_RELAXED, __HIP_MEMORY_SCOPE_AGENT) == G - 1u) {
            __hip_atomic_store(ctlw + CW_BAR + 64, 0u, __ATOMIC_RELAXED, __HIP_MEMORY_SCOPE_AGENT);
            __hip_atomic_store(ctlw + CW_BAR + 128, 0u, __ATOMIC_RELAXED, __HIP_MEMORY_SCOPE_AGENT);
        }
    }
}
__device__ __forceinline__ void simple_barrier(unsigned* ctlw, volatile LAS unsigned* misc) {
    unsigned* cnt = ctlw + CW_BAR + 64;
    asm volatile("s_waitcnt vmcnt(0)" ::: "memory");
#ifdef MK_DIAG
    { const int w = __builtin_amdgcn_readfirstlane(threadIdx.x >> 6);
      if ((threadIdx.x & 63) == 0) misc[16 + w] = misc[16 + w] + 1u; }
#endif
    __syncthreads();
    if (threadIdx.x == 0) {
        const unsigned e = misc[10] + 1u; misc[10] = e;
#ifdef MK_DIAG
        { unsigned bad = 0; for (int w = 0; w < 8; ++w) bad |= (misc[16 + w] != e); if (bad) atomicMax(ctlw + CW_CODE, 3u); }
        __hip_atomic_store(ctlw + 8192 + 64 * blockIdx.x, e, __ATOMIC_RELAXED, __HIP_MEMORY_SCOPE_WORKGROUP);
        asm volatile("s_waitcnt vmcnt(0)" ::: "memory");
#endif
#ifdef MK_SYS_FENCE
        __builtin_amdgcn_fence(__ATOMIC_RELEASE, "");
#else
        __builtin_amdgcn_fence(__ATOMIC_RELEASE, "agent");
#endif
        asm volatile("s_waitcnt vmcnt(0)" ::: "memory");
#ifdef DG_DELAY
        { const unsigned long long td = __builtin_amdgcn_s_memrealtime(); while (__builtin_amdgcn_s_memrealtime() - td < 5000ull) __builtin_amdgcn_s_sleep(8); }
#endif
        const unsigned want = e * (gridDim.x * gridDim.y * gridDim.z);
        __hip_atomic_fetch_add(cnt, 1u, __ATOMIC_RELAXED, __HIP_MEMORY_SCOPE_AGENT);
        const unsigned long long t0 = __builtin_amdgcn_s_memrealtime();
        while (__hip_atomic_load(cnt, __ATOMIC_RELAXED, __HIP_MEMORY_SCOPE_AGENT) < want) {
            __builtin_amdgcn_s_sleep(2);
            if (__builtin_amdgcn_s_memrealtime() - t0 > 5000000ull) { atomicMax(ctlw + CW_CODE, 1u); break; }
        }
#ifdef MK_SYS_FENCE
        __builtin_amdgcn_fence(__ATOMIC_ACQUIRE, "");
#else
        __builtin_amdgcn_fence(__ATOMIC_ACQUIRE, "agent");
#endif
        asm volatile("s_waitcnt vmcnt(0)" ::: "memory");
    }
    __syncthreads();
#ifdef MK_DIAG
    { const unsigned e = misc[10];
      const unsigned other = (blockIdx.x * 37u + threadIdx.x) % (gridDim.x);
      const unsigned v = *(const volatile unsigned*)(ctlw + 8192 + 64 * other);
      if (v != e) atomicMax(ctlw + CW_CODE, 2u); }
#endif
}
#ifdef MK_SIMPLE_BAR
#define GRID_BARRIER() simple_barrier((unsigned*)F.ctl, F.MISC)
#else
#define GRID_BARRIER() xcd_barrier(bar)
#endif

struct Args { const float* in[23]; float* out; unsigned char* ws; int ph_lo, ph_hi, li, pad; };
struct Frame {
    LAS unsigned char* lds;
    volatile LAS unsigned* MISC;
    gu32* ctl;
    int tid, lane, wave, vcu, G;
};

struct GemmParams { const bf16* A; const bf16* Bt; size_t bgbytes; int lda, ldb, K, bgt, gM, gN, crot, is_gemm, gsz, cskip; };
static_assert(sizeof(pg8::EpiParams) <= 128 && sizeof(GemmParams) <= 72 && PT_OFF + 24 * 8 <= LDS_BYTES, "LDS parameter blocks");
__device__ __forceinline__ unsigned long long rfl64(unsigned long long v) {
    const unsigned lo = __builtin_amdgcn_readfirstlane((unsigned)v), hi = __builtin_amdgcn_readfirstlane((unsigned)(v >> 32)); return ((unsigned long long)hi << 32) | lo; }
__device__ __forceinline__ void conv_item(const float* W, int ldw, int Ksrc, int srccol, const float* gain, bf16* WT, int ldk, int dstrow0, int k0, LAS float* scr, int lane) {
    const bool zero = (srccol < 0) || (k0 >= Ksrc);
    const int r8 = lane >> 3, c4 = (lane & 7) * 4;
    f32x4 v[8];
    if (!zero) {
#pragma unroll
        for (int i = 0; i < 8; ++i) v[i] = *(const GAS f32x4*)(unsigned long long)(W + (size_t)(k0 + 8 * i + r8) * ldw + srccol + c4);
        if (gain) {
#pragma unroll
            for (int i = 0; i < 8; ++i) v[i] = v[i] * gain[k0 + 8 * i + r8];
        }
    } else {
#pragma unroll
        for (int i = 0; i < 8; ++i) v[i] = (f32x4){0.f, 0.f, 0.f, 0.f};
    }
#pragma unroll
    for (int i = 0; i < 8; ++i) { LAS float* d = scr + (8 * i + r8) * 33 + c4; d[0] = v[i][0]; d[1] = v[i][1]; d[2] = v[i][2]; d[3] = v[i][3]; }
    LDS_WAIT(); asm volatile("" ::: "memory");
    const int c = lane & 7;
#pragma unroll
    for (int j = 0; j < 4; ++j) { const int n = (lane >> 3) + 8 * j; const LAS float* sp = scr + (8 * c) * 33 + n;
        v4u o; o.x = pk2(sp[0 * 33], sp[1 * 33]); o.y = pk2(sp[2 * 33], sp[3 * 33]); o.z = pk2(sp[4 * 33], sp[5 * 33]); o.w = pk2(sp[6 * 33], sp[7 * 33]);
        gst16(WT, WT + (size_t)(dstrow0 + n) * ldk + k0 + 8 * c, o); }
    LDS_WAIT(); asm volatile("" ::: "memory");
}
__device__ __forceinline__ int map_pair(int n0, int half_off) { const int pn = n0 >> 8, t = n0 & 255; return (t >> 7) * half_off + 128 * pn + (t & 127); }
__device__ __forceinline__ int map_dkv(int t) { if (t < 64) return t; if (t < 96) return 128 + (t - 64); if (t < 128) return -1; if (t < 192) return 64 + (t - 128); if (t < 224) return 160 + (t - 192); return -1; }
__device__ __forceinline__ int map_uq(int n0) {
    if (n0 < 1024) { const int pn = n0 >> 8, t = n0 & 255; return (2 * pn + (t >> 7)) * 192 + (t & 127); }
    const int r = n0 - 1024, q = r >> 8, t = r & 255, bj = t >> 7, hh = (t & 127) >> 5; return (4 * q + hh) * 192 + 128 + 32 * bj + (t & 31);
}
struct ConvJob { const float* W; int ldw, Ksrc, Kdst, Ndst, map; const float* gain; bf16* WT; int ldk; };
__device__ __forceinline__ void conv_job_item(const ConvJob& j, int item, LAS float* scr, int lane) {
    const int nblk = j.Ndst / 32, kb = item / nblk, nb = item % nblk, k0 = 64 * kb, n0 = 32 * nb;
    int sc;
    switch (j.map) { case 1: sc = map_pair(n0, FF); break; case 2: sc = map_pair(n0, 1024); break; case 3: sc = map_dkv(n0); break; case 4: sc = map_uq(n0); break; default: sc = n0; }
    conv_item(j.W, j.ldw, j.Ksrc, sc, j.gain, j.WT, j.ldk, n0, k0, scr, lane);
}

__device__ __forceinline__ void xconv_rows(Frame& F, const float* x, bf16* xb, float* rss) {
    const int gw = F.vcu * NWAVES + F.wave, NGW = F.G * NWAVES;
    for (int m = gw; m < M; m += NGW) {
        const GAS f32x4* xr = (const GAS f32x4*)(x + (size_t)m * D) + F.lane;
        f32x4 v[4]; float s = 0.f;
#pragma unroll
        for (int j = 0; j < 4; ++j) { v[j] = xr[64 * j]; s += (v[j].x * v[j].x + v[j].y * v[j].y) + (v[j].z * v[j].z + v[j].w * v[j].w); }
        s = wave_sum(s);
        if (F.lane == 0) gst4f(rss, rss + m, s);
        v2u* o8 = (v2u*)(xb + (size_t)m * D) + F.lane;
#pragma unroll
        for (int j = 0; j < 4; ++j) { v2u w; w.x = pk2(v[j].x, v[j].y); w.y = pk2(v[j].z, v[j].w);
            gst8(xb, o8 + 64 * j, w);
        }
    }
}
__device__ __forceinline__ void rss_rows(Frame& F, const float* x, float* rss) {
    const int gw = F.vcu * NWAVES + F.wave, NGW = F.G * NWAVES;
    for (int m = gw; m < M; m += NGW) {
        const GAS f32x4* xr = (const GAS f32x4*)(x + (size_t)m * D) + F.lane;
        float s = 0.f;
#pragma unroll
        for (int j = 0; j < 4; ++j) { const f32x4 v = xr[64 * j]; s += (v.x * v.x + v.y * v.y) + (v.z * v.z + v.w * v.w); }
        s = wave_sum(s);
        if (F.lane == 0) rss[m] = s;
    }
}
__device__ __forceinline__ void uconv_rows(Frame& F, const float* x, const float* rss, int nslot, const float* gain, bf16* ug) {
    const int gw = F.vcu * NWAVES + F.wave, NGW = F.G * NWAVES;
    f32x4 gv[4];
#pragma unroll
    for (int j = 0; j < 4; ++j) gv[j] = *(const f32x4*)(gain + F.lane * 16 + 4 * j);
    for (int m = gw; m < M; m += NGW) {
        const float r = __builtin_amdgcn_rsqf(wave_sum(F.lane < nslot ? gld4f(rss, rss + (size_t)m * nslot + F.lane) : 0.f) * (1.f / 1024.f) + EPS);
        const f32x4* xr = (const f32x4*)(x + (size_t)m * D + F.lane * 16);
        f32x4 v[4];
#pragma unroll
        for (int j = 0; j < 4; ++j) v[j] = gld16f(x, xr + j) * gv[j] * r;
        v4u w0, w1;
        w0.x = pk2(v[0].x, v[0].y); w0.y = pk2(v[0].z, v[0].w); w0.z = pk2(v[1].x, v[1].y); w0.w = pk2(v[1].z, v[1].w);
        w1.x = pk2(v[2].x, v[2].y); w1.y = pk2(v[2].z, v[2].w); w1.z = pk2(v[3].x, v[3].y); w1.w = pk2(v[3].z, v[3].w);
        bf16* dst = ug + ((size_t)F.lane * 1024 + (m >> 4)) * 384 + (m & 15) * 16;
        gst16(ug, dst, w0); gst16(ug, dst + 8, w1);
    }
}
__device__ __forceinline__ void s5_tables(Frame& F, int g, const float* lam_re, const float* lam_im, const float* log_step, const float* b_re, const float* b_im,
                                          const float* c_re, const float* c_im, bf16* TH, bf16* GT, float* L16) {
    LAS float* L = (LAS float*)(F.lds + RING_OFF);
    LAS float* pwr = L;
    LAS float* pwi = L + 17 * 64;
    LAS float* bbr = L + 34 * 64;
    LAS float* bbi = bbr + 1024;
    LAS float* ccr = bbi + 1024;
    LAS float* cci = ccr + 1024;
    LAS float* Kt = cci + 1024;
    const int tid = F.tid;
    if (tid < 64) {
        const int p = tid;
        const float step = expf(log_step[g]);
        const float lr = lam_re[g * 64 + p], li = lam_im[g * 64 + p];
        const double ang1 = (double)li * (double)step;
        for (int tau = 0; tau <= 16; ++tau) {
            double a = ang1 * (double)tau; a -= 6.283185307179586476925 * __builtin_rint(a * 0.15915494309189533577);
            const float mag = expf(lr * step * (float)tau), af = (float)a;
            pwr[tau * 64 + p] = mag * cosf(af); pwi[tau * 64 + p] = mag * sinf(af);
        }
        const float lbr = pwr[64 + p], lbi = pwi[64 + p];
        const float nr = lbr - 1.f, ni = lbi, den = lr * lr + li * li;
        const float cr = (nr * lr + ni * li) / den, ci = (ni * lr - nr * li) / den;
        for (int i = 0; i < 16; ++i) { const float br = b_re[((size_t)g * 64 + p) * 16 + i], bi = b_im[((size_t)g * 64 + p) * 16 + i];
            bbr[p * 16 + i] = cr * br - ci * bi; bbi[p * 16 + i] = cr * bi + ci * br; }
        gst4f(L16, L16 + (g * 64 + p) * 2, pwr[16 * 64 + p]); gst4f(L16, L16 + (g * 64 + p) * 2 + 1, pwi[16 * 64 + p]);
    }
    for (int i = tid; i < 1024; i += 512) { ccr[i] = c_re[(size_t)g * 1024 + i]; cci[i] = c_im[(size_t)g * 1024 + i]; }
    __syncthreads();
    for (int e = tid; e < 4096; e += 512) {
        const int tau = e >> 8, o = (e >> 4) & 15, i = e & 15; float acc = 0.f;
        for (int p = 0; p < 64; ++p) {
            const float cr = ccr[o * 64 + p], ci = cci[o * 64 + p], wr_ = pwr[tau * 64 + p], wi_ = pwi[tau * 64 + p];
            const float zr = cr * wr_ - ci * wi_, zi = cr * wi_ + ci * wr_;
            acc += zr * bbr[p * 16 + i] - zi * bbi[p * 16 + i];
        }
        Kt[e] = acc;
    }
    __syncthreads();
    bf16* THg = TH + (size_t)g * 256 * 384;
    for (int q = tid; q < 256 * 48; q += 512) {
        const int rowi = q / 48, ch = q % 48, t = rowi >> 4, o = rowi & 15; float v[8];
        if (ch < 32) { const int s = ch >> 1, ih = ch & 1;
#pragma unroll
            for (int e = 0; e < 8; ++e) v[e] = (s <= t) ? Kt[((t - s) * 16 + o) * 16 + ih * 8 + e] : 0.f;
        } else { const int k = (ch - 32) * 8;
#pragma unroll
            for (int e = 0; e < 8; ++e) { const int kk = k + e, p = kk & 63;
                const float cr = ccr[o * 64 + p], ci = cci[o * 64 + p], wr_ = pwr[(t + 1) * 64 + p], wi_ = pwi[(t + 1) * 64 + p];
                v[e] = (kk < 64) ? (cr * wr_ - ci * wi_) : -(cr * wi_ + ci * wr_); }
        }
        v4u w; w.x = pk2(v[0], v[1]); w.y = pk2(v[2], v[3]); w.z = pk2(v[4], v[5]); w.w = pk2(v[6], v[7]);
        gst16(TH, THg + (size_t)rowi * 384 + ch * 8, w);
    }
    bf16* GTg = GT + (size_t)g * 256 * 256;
    for (int q = tid; q < 256 * 32; q += 512) {
        const int rc = q >> 5, ch = q & 31, s = ch >> 1, ih = ch & 1, p = rc & 63; float v[8];
#pragma unroll
        for (int e = 0; e < 8; ++e) {
            if (rc < 128) { const float wr_ = pwr[(15 - s) * 64 + p], wi_ = pwi[(15 - s) * 64 + p], br = bbr[p * 16 + ih * 8 + e], bi = bbi[p * 16 + ih * 8 + e];
                v[e] = (rc < 64) ? (wr_ * br - wi_ * bi) : (wr_ * bi + wi_ * br); }
            else v[e] = 0.f;
        }
        v4u w; w.x = pk2(v[0], v[1]); w.y = pk2(v[2], v[3]); w.z = pk2(v[4], v[5]); w.w = pk2(v[6], v[7]);
        gst16(GT, GTg + (size_t)rc * 256 + ch * 8, w);
    }
    __syncthreads();
}
__device__ __forceinline__ void carry_scan(Frame& F, const float* Send, const float* L16, bf16* ug) {
    const int id = F.wave * F.G + F.vcu;
    if (id >= BATCH * NG) return;
    const int b = id / NG, g = id % NG, p = F.lane;
    const float lr = gld4f(L16, L16 + (g * 64 + p) * 2), li = gld4f(L16, L16 + (g * 64 + p) * 2 + 1);
    float xr = 0.f, xi = 0.f;
    const size_t row0 = (size_t)g * 1024 + b * 128;
    for (int c0 = 0; c0 < 128; c0 += 8) {
        float sr[8], si[8];
#pragma unroll
        for (int k = 0; k < 8; ++k) { sr[k] = gld4f(Send, Send + (row0 + c0 + k) * 128 + p); si[k] = gld4f(Send, Send + (row0 + c0 + k) * 128 + 64 + p); }
#pragma unroll
        for (int k = 0; k < 8; ++k) {
            bf16* dst = ug + (row0 + c0 + k) * 384 + 256;
            gst2(ug, dst + p, (bf16)f2bf(xr)); gst2(ug, dst + 64 + p, (bf16)f2bf(xi));
            const float nr = lr * xr - li * xi + sr[k], ni = lr * xi + li * xr + si[k];
            xr = nr; xi = ni;
        }
    }
}
__device__ __forceinline__ void rope_tables(Frame& F, const int* pos, float* ctab, float* stab) {
    const int gt = F.vcu * (NWAVES * 64) + F.tid, NT = F.G * NWAVES * 64;
    for (int e = gt; e < M * 32; e += NT) {
        const int m = e >> 5, j = e & 31;
        const float invf = __builtin_amdgcn_exp2f(-(float)(2 * j) * (13.287712379549449f / 64.0f));
        const float ang = (float)pos[m] * invf;
        gst4f(ctab, ctab + e, cosf(ang)); gst4f(stab, stab + e, sinf(ang));
    }
}
__device__ __forceinline__ void final_norm_rows(Frame& F, float* x, const float* rss, int nslot, const float* gain) {
    const int gw = F.vcu * NWAVES + F.wave, NGW = F.G * NWAVES;
#ifdef MK_DIAG
    const float diag_scale = 1.f + 2.f * (float)__hip_atomic_load((unsigned*)F.ctl + CW_CODE, __ATOMIC_RELAXED, __HIP_MEMORY_SCOPE_AGENT);
#else
    const float diag_scale = 1.f;
#endif
    f32x4 gv[4];
#pragma unroll
    for (int j = 0; j < 4; ++j) gv[j] = *((const f32x4*)gain + F.lane + 64 * j);
    for (int m = gw; m < M; m += NGW) {
        const float r = diag_scale * __builtin_amdgcn_rsqf(wave_sum(F.lane < nslot ? gld4f(rss, rss + (size_t)m * nslot + F.lane) : 0.f) * (1.f / 1024.f) + EPS);
        f32x4* xr = (f32x4*)(x + (size_t)m * D) + F.lane;
#pragma unroll
        for (int j = 0; j < 4; ++j) gst16f(x, xr + 64 * j, gld16f(x, xr + 64 * j) * gv[j] * r);
    }
}

enum Phase { PH_PRO = 0, PH_UP00, PH_DN00, PH_UCONV, PH_SEND, PH_CARRY, PH_YG, PH_GLU, PH_UP01, PH_DN01, PH_DKV, PH_UP10, PH_DN10, PH_UKV, PH_DQ, PH_UQ, PH_ATTN, PH_WO, PH_UP11, PH_DN11, PH_FIN, PH_N };
__device__ __forceinline__ bool bar_after(int p) { return !(p == PH_DKV || p == PH_UKV || p == PH_FIN); }

template <int ph> __device__ __forceinline__ void phase_body(Frame& F, const Args& args, unsigned char* ws, const XcdBarrier& bar, int hi, unsigned char* lds) {
        int tid_ = threadIdx.x, bx_ = blockIdx.x; asm volatile("" : "+v"(tid_)); asm volatile("" : "+s"(bx_));
        { unsigned long long wsi = (unsigned long long)ws; asm volatile("" : "+s"(wsi) :: "memory"); ws = (unsigned char*)(GAS unsigned char*)wsi; }
        const LAS unsigned long long* PT = (const LAS unsigned long long*)(F.lds + PT_OFF);
#define INP(k) ((const float*)(const GAS float*)rfl64(PT[k]))
#define OUTP ((float*)(GAS float*)rfl64(PT[23]))
        F.tid = tid_; F.lane = tid_ & 63; F.wave = __builtin_amdgcn_readfirstlane(tid_ >> 6);
        F.vcu = (F.G % 8 == 0) ? (bx_ % 8) * (F.G / 8) + bx_ / 8 : bx_;
        F.ctl = (gu32*)(ws + WS_CTL);
        float* rss0 = (float*)(ws + WS_RSS);
#define RSP(id) ((float*)(ws + WS_RSP + rs_off(id)))
        bf16* xb = (bf16*)(ws + WS_XB); bf16* act = (bf16*)(ws + WS_ACT);
        bf16* Win_t = (bf16*)(ws + WS_WIN); bf16* Wout_t = (bf16*)(ws + WS_WOUT);
        float* ctab = (float*)(ws + WS_ROPE); float* stab = ctab + (size_t)M * 32;
        bf16* ug = (bf16*)(ws + WS_UG); bf16* yb = (bf16*)(ws + WS_Y); float* Send = (float*)(ws + WS_SEND); float* L16 = (float*)(ws + WS_L16);
        bf16* Kn = (bf16*)(ws + WS_KN); bf16* Vb = (bf16*)(ws + WS_V); bf16* Kr = (bf16*)(ws + WS_KR); bf16* lat = (bf16*)(ws + WS_LAT); bf16* cq = (bf16*)(ws + WS_CQ);
        bf16* Qb = (bf16*)(ws + WS_Q); bf16* Ob = (bf16*)(ws + WS_O);
        LAS pg8::EpiParams* ep = (LAS pg8::EpiParams*)(F.lds + EPI_OFF);
        LAS GemmParams* gp = (LAS GemmParams*)(F.lds + GP_OFF);
        const bool t0 = (tid_ == 0);
        if (t0) { gp->is_gemm = 0; gp->bgt = 1 << 30; gp->bgbytes = 0; gp->gM = M; gp->crot = 0; gp->gsz = 0; gp->cskip = 0; ep->rss_in = nullptr; ep->rss_out = nullptr; ep->rs_lds = 0; }
#define GP_SET(A_, Bt_, lda_, ldb_, K_, gN_) do { gp->is_gemm = 1; gp->A = (A_); gp->Bt = (Bt_); gp->lda = (lda_); gp->ldb = (ldb_); gp->K = (K_); gp->gN = (gN_); } while (0)
        switch (ph) {
        case PH_PRO: {
            LAS float* scr = (LAS float*)(F.lds + RING_OFF + F.wave * 16384);
            const bool tbl_wg = (F.G == 256) && ((F.vcu & 3) == 0);
            const int gw = (F.G == 256) ? (3 * (F.vcu >> 2) + (F.vcu & 3) - 1) * NWAVES + F.wave : F.vcu * NWAVES + F.wave, NGW = (F.G == 256 ? 192 : F.G) * NWAVES;
            constexpr int I_IN = (D / 64) * (2 * FF / 32), I_OUT = (FF / 64) * (D / 32), I_GLU = 16 * 64, I_DKV = 16 * 8, I_UKV = 4 * 64, I_DQ = 16 * 8, I_UQ = 4 * 48, I_O = 16 * 32;
            constexpr int NITEMS = 4 * I_IN + 4 * I_OUT + I_GLU + I_DKV + I_UKV + I_DQ + I_UQ + I_O;
            if (tbl_wg) s5_tables(F, F.vcu >> 2, INP(5), INP(6), INP(7), INP(8), INP(9), INP(10), INP(11), (bf16*)(ws + WS_TH), (bf16*)(ws + WS_GT), L16);
            else for (int it = gw; it < NITEMS; it += NGW) {
                int r = it; ConvJob j;
                if (r < 4 * I_IN) { const int idx = r / I_IN; r -= idx * I_IN; const int l = idx >> 1, jj = idx & 1;
                    j = ConvJob{INP(3) + (size_t)idx * D * 2 * FF, 2 * FF, D, D, 2 * FF, 1, INP(2) + (size_t)(l * 3 + (jj ? 2 : 0)) * D, Win_t + (size_t)idx * 2 * FF * D, D}; }
                else if ((r -= 4 * I_IN) < 4 * I_OUT) { const int idx = r / I_OUT; r -= idx * I_OUT;
                    j = ConvJob{INP(4) + (size_t)idx * FF * D, D, FF, FF, D, 0, nullptr, Wout_t + (size_t)idx * D * FF, FF}; }
                else if ((r -= 4 * I_OUT) < I_GLU) j = ConvJob{INP(13), 2048, 1024, 1024, 2048, 2, nullptr, (bf16*)(ws + WS_WGLU), 1024};
                else if ((r -= I_GLU) < I_DKV) j = ConvJob{INP(15), 192, 1024, 1024, 256, 3, INP(14), (bf16*)(ws + WS_WDKV), 1024};
                else if ((r -= I_DKV) < I_UKV) j = ConvJob{INP(17), 2048, 128, 256, 2048, 0, INP(16), (bf16*)(ws + WS_WUKV), P256};
                else if ((r -= I_UKV) < I_DQ) j = ConvJob{INP(18), 256, 1024, 1024, 256, 0, INP(2) + (size_t)(3 + 1) * D, (bf16*)(ws + WS_WDQ), 1024};
                else if ((r -= I_DQ) < I_UQ) j = ConvJob{INP(20), 1536, 256, 256, 1536, 4, INP(19), (bf16*)(ws + WS_WUQ), P256};
                else { r -= I_UQ; j = ConvJob{INP(21), 1024, 1024, 1024, 1024, 0, nullptr, (bf16*)(ws + WS_WO), 1024}; }
                conv_job_item(j, r, scr, F.lane);
            }
            __syncthreads();
            xconv_rows(F, INP(0), xb, rss0);
            rope_tables(F, (const int*)INP(1), ctab, stab);
            if (F.G != 256 && (F.vcu & 3) == 0 && (F.vcu >> 2) < NG)
                s5_tables(F, F.vcu >> 2, INP(5), INP(6), INP(7), INP(8), INP(9), INP(10), INP(11), (bf16*)(ws + WS_TH), (bf16*)(ws + WS_GT), L16);
            { const int gt = F.vcu * (NWAVES * 64) + F.tid, NT = F.G * NWAVES * 64;
              for (int e = gt; e < M * 16; e += NT) { const int m = e >> 4, c = e & 15; gst16(lat, lat + (size_t)m * P256 + 128 + c * 8, (v4u){0u, 0u, 0u, 0u}); } }
        } break;
        case PH_UP00: case PH_UP01: case PH_UP10: case PH_UP11:
#ifdef MK_DIAG
            if (ph == PH_UP00 && hi - ph > 1 && ph > 0 || (ph == PH_UP00 && hi > 1 && ph == 1)) {
                const int m = bx_ * 64 + (tid_ >> 3), c = (tid_ & 7) * 128 + 6;
                const float* xin = INP(0);
                const unsigned want = pk2(xin[(size_t)m * D + c], xin[(size_t)m * D + c + 1]);
                const unsigned got_plain = *(const volatile unsigned*)(xb + (size_t)m * D + c);
                const unsigned got_sc1 = __hip_atomic_load((const unsigned*)(xb + (size_t)m * D + c), __ATOMIC_RELAXED, __HIP_MEMORY_SCOPE_SYSTEM);
                if (got_sc1 != want) atomicMax((unsigned*)F.ctl + CW_CODE, 3u);
                else if (got_plain != want) atomicMax((unsigned*)F.ctl + CW_CODE, 2u);
            }
#endif
#ifdef DIAG_RSSFIX
            if (ph == PH_UP01 && hi - ph > 1 && ph > 0) { rss_rows(F, OUTP, RSP(RS_X2)); GRID_BARRIER(); }
#endif
            {
            const int idx = (ph == PH_UP00) ? 0 : (ph == PH_UP01) ? 1 : (ph == PH_UP10) ? 2 : 3;
            const int rsi = (ph == PH_UP00) ? RS_X0 : (ph == PH_UP01) ? RS_X2 : (ph == PH_UP10) ? RS_X3 : RS_X5;
            const float* rsp = (rsi == RS_X0) ? rss0 : (rsi == RS_X2) ? RSP(RS_X2) : (rsi == RS_X3) ? RSP(RS_X3) : RSP(RS_X5);
            if (F.G == 256) {
                const int ns = rs_slots(rsi), r0 = (bx_ & 7) * 2048 + tid_ * 4;
                f32x4 sq = (f32x4){0.f, 0.f, 0.f, 0.f};
                if (ns == 1) sq = gld16f(rsp, rsp + r0);
                else {
#pragma unroll
                    for (int rr = 0; rr < 4; ++rr) { float a = 0.f;
                        for (int q = 0; q < ns; q += 4) { const f32x4 v = gld16f(rsp, rsp + (size_t)(r0 + rr) * ns + q); a += (v[0] + v[1]) + (v[2] + v[3]); }
                        sq[rr] = a; }
                }
                f32x4 rsv;
#pragma unroll
                for (int rr = 0; rr < 4; ++rr) rsv[rr] = __builtin_amdgcn_rsqf(sq[rr] * (1.f / 1024.f) + EPS);
                *(LAS f32x4*)(F.lds + RSL_OFF + tid_ * 16) = rsv;
            }
            if (t0) {
            GP_SET(xb, Win_t + (size_t)idx * 2 * FF * D, D, D, D, 2 * FF);
            ep->mode = pg8::EM_SWIGLU; ep->rss_n = rs_slots(rsi); ep->inv_k = 1.f / 1024.f;
            if (F.G == 256) { ep->rss_in = nullptr; ep->rs_lds = RSL_OFF - EPI_OFF; } else ep->rss_in = rsp; ep->ob = act; ep->ldo = FF;
            } }
            break;
        case PH_DN00: case PH_DN01: case PH_DN10: case PH_DN11: if (t0) {
            const int idx = (ph == PH_DN00) ? 0 : (ph == PH_DN01) ? 1 : (ph == PH_DN10) ? 2 : 3;
            const int rso = (ph == PH_DN00) ? RS_X1 : (ph == PH_DN01) ? RS_X3 : (ph == PH_DN10) ? RS_X4 : RS_X6;
            GP_SET(act, Wout_t + (size_t)idx * D * FF, FF, FF, FF, D);
            ep->mode = pg8::EM_RES; ep->base = (ph == PH_DN00) ? INP(0) : OUTP; ep->out = OUTP; ep->alpha = 0.5f; ep->ob = xb; ep->rss_out = (rso == RS_X1) ? RSP(RS_X1) : (rso == RS_X3) ? RSP(RS_X3) : (rso == RS_X4) ? RSP(RS_X4) : RSP(RS_X6);
        } break;
        case PH_UCONV: uconv_rows(F, OUTP, RSP(RS_X1), rs_slots(RS_X1), INP(2) + 1 * D, ug); break;
        case PH_SEND: if (t0) {
            GP_SET(ug, (const bf16*)(ws + WS_GT), 384, 256, 256, 256); gp->gM = NG * 1024; gp->bgt = 4; gp->bgbytes = (size_t)256 * 256 * 2;
            ep->mode = pg8::EM_SEND; ep->fout = Send;
        } break;
        case PH_CARRY: carry_scan(F, Send, L16, ug); break;
        case PH_YG: if (t0) {
            GP_SET(ug, (const bf16*)(ws + WS_TH), 384, 384, 384, 256); gp->gM = NG * 1024; gp->bgt = 4; gp->bgbytes = (size_t)256 * 384 * 2;
            ep->mode = pg8::EM_Y; ep->ua = ug; ep->aux0 = INP(12); ep->ob = yb;
        } break;
        case PH_GLU: if (t0) {
            GP_SET(yb, (const bf16*)(ws + WS_WGLU), D, D, D, 2048);
            ep->mode = pg8::EM_GLU; ep->base = OUTP; ep->out = OUTP; ep->ob = xb; ep->rss_out = RSP(RS_X2);
        } break;
        case PH_DKV: if (t0) {
            GP_SET(xb, (const bf16*)(ws + WS_WDKV), D, D, D, 256); gp->crot = 128;
            ep->mode = pg8::EM_DKV; ep->rss_in = RSP(RS_X3); ep->rss_n = rs_slots(RS_X3); ep->inv_k = 1.f / 1024.f; ep->ob = lat; ep->ob2 = Kr; ep->rss_out = RSP(RS_LAT); ep->aux0 = ctab; ep->aux1 = stab;
        } break;
        case PH_UKV: if (t0) {
            GP_SET(lat, (const bf16*)(ws + WS_WUKV), P256, P256, 256, 2048); if (F.G == 256) { gp->gsz = 192; gp->cskip = 64; }
            ep->mode = pg8::EM_UKV; ep->rss_in = RSP(RS_LAT); ep->rss_n = rs_slots(RS_LAT); ep->inv_k = 1.f / 128.f; ep->ob = Kn; ep->ob2 = Vb;
        } break;
        case PH_DQ: if (t0) {
            GP_SET(xb, (const bf16*)(ws + WS_WDQ), D, D, D, 256);
            ep->mode = pg8::EM_DQ; ep->rss_in = RSP(RS_X4); ep->rss_n = rs_slots(RS_X4); ep->inv_k = 1.f / 1024.f; ep->ob = cq; ep->rss_out = RSP(RS_Q);
        } break;
        case PH_UQ: if (t0) {
            GP_SET(cq, (const bf16*)(ws + WS_WUQ), P256, P256, 256, 1536);
            ep->mode = pg8::EM_UQ; ep->rss_in = RSP(RS_Q); ep->rss_n = rs_slots(RS_Q); ep->inv_k = 1.f / 256.f; ep->ob = Qb; ep->alpha = QSCALE; ep->aux0 = ctab; ep->aux1 = stab;
        } break;
        case PH_ATTN: attn::attn_phase((char*)lds + RING_OFF, Qb, Kn, Kr, Vb, Ob, F.vcu, F.G, tid_); break;
        case PH_WO: if (t0) {
            GP_SET(Ob, (const bf16*)(ws + WS_WO), D, D, D, D);
            ep->mode = pg8::EM_RES; ep->base = OUTP; ep->out = OUTP; ep->alpha = 1.0f; ep->ob = xb; ep->rss_out = RSP(RS_X5);
        } break;
        case PH_FIN: final_norm_rows(F, OUTP, RSP(RS_X6), rs_slots(RS_X6), INP(22)); break;
        default: break;
        }
#undef GP_SET
#undef INP
#undef OUTP
        __syncthreads();
        if (__builtin_amdgcn_readfirstlane(gp->is_gemm)) {
            pg8::Gemm g;
            g.A = (const bf16*)(const GAS bf16*)rfl64((unsigned long long)gp->A); g.Bt = (const bf16*)(const GAS bf16*)rfl64((unsigned long long)gp->Bt);
            g.lda = __builtin_amdgcn_readfirstlane(gp->lda); g.ldb = __builtin_amdgcn_readfirstlane(gp->ldb); g.K = __builtin_amdgcn_readfirstlane(gp->K);
            g.bgt = __builtin_amdgcn_readfirstlane(gp->bgt); g.bgbytes = (size_t)rfl64((unsigned long long)gp->bgbytes);
            const int gM = __builtin_amdgcn_readfirstlane(gp->gM), gN = __builtin_amdgcn_readfirstlane(gp->gN), crot = __builtin_amdgcn_readfirstlane(gp->crot);
            const int gsz = __builtin_amdgcn_readfirstlane(gp->gsz), cskip = __builtin_amdgcn_readfirstlane(gp->cskip);
            const int cc = (int)((bx_ + crot) % F.G) - cskip;
            if (cc >= 0) {
                pg8::StaticOrder S; S.init(gM, gN, gsz ? gsz : F.G, cc);
                pg8::EpiDyn ED{(const LAS pg8::EpiParams*)(F.lds + EPI_OFF)};
                pg8::gemm_phase<pg8::EpiDyn, pg8::StaticOrder, true, true>(F.lds + RING_OFF, g, S, ED, tid_);
            }
        }
        if (ph + 1 < hi && bar_after(ph)) { GRID_BARRIER();
#ifdef DUP_BAR
            GRID_BARRIER();
#endif
        }
        __syncthreads();
}

__global__ void __launch_bounds__(NWAVES * 64, 2) mk_fwd(Args args) {
    extern __shared__ __attribute__((aligned(16))) unsigned char lds[];
    Frame F;
    F.lds = (LAS unsigned char*)lds;
    F.MISC = (volatile LAS unsigned*)(F.lds + MISC_OFF);
    F.tid = threadIdx.x; F.lane = F.tid & 63; F.wave = __builtin_amdgcn_readfirstlane(F.tid >> 6);
    F.G = gridDim.x; { const int bx = blockIdx.x; F.vcu = (F.G % 8 == 0) ? (bx % 8) * (F.G / 8) + bx / 8 : bx; }
    unsigned char* ws = args.ws;
    F.ctl = (gu32*)(ws + WS_CTL);
    for (int u = F.tid; u < (LDS_BYTES - LDSCTL_OFF) / 4; u += NWAVES * 64) ((LAS unsigned*)(F.lds + LDSCTL_OFF))[u] = 0u;
    __syncthreads();
    if (F.tid == 0) { LAS unsigned long long* pt = (LAS unsigned long long*)(F.lds + PT_OFF);
        pt[0] = (unsigned long long)args.in[0];
        pt[1] = (unsigned long long)args.in[1];
        pt[2] = (unsigned long long)args.in[2];
        pt[3] = (unsigned long long)args.in[3];
        pt[4] = (unsigned long long)args.in[4];
        pt[5] = (unsigned long long)args.in[5];
        pt[6] = (unsigned long long)args.in[6];
        pt[7] = (unsigned long long)args.in[7];
        pt[8] = (unsigned long long)args.in[8];
        pt[9] = (unsigned long long)args.in[9];
        pt[10] = (unsigned long long)args.in[10];
        pt[11] = (unsigned long long)args.in[11];
        pt[12] = (unsigned long long)args.in[12];
        pt[13] = (unsigned long long)args.in[13];
        pt[14] = (unsigned long long)args.in[14];
        pt[15] = (unsigned long long)args.in[15];
        pt[16] = (unsigned long long)args.in[16];
        pt[17] = (unsigned long long)args.in[17];
        pt[18] = (unsigned long long)args.in[18];
        pt[19] = (unsigned long long)args.in[19];
        pt[20] = (unsigned long long)args.in[20];
        pt[21] = (unsigned long long)args.in[21];
        pt[22] = (unsigned long long)args.in[22];
        pt[23] = (unsigned long long)args.out; }
    __syncthreads();
    XcdBarrier bar; bar.bar = (unsigned*)(F.ctl + CW_BAR) + args.li * XCD_BAR_WORDS; bar.x = 0; bar.st = nullptr;
    const int lo = args.ph_lo, hi = args.ph_hi;
#ifdef MK_SIMPLE_BAR
    if (hi - lo > 1) sb_begin((unsigned*)F.ctl);
#else
    if (hi - lo > 1) bar = xcd_barrier_post((unsigned*)(F.ctl + CW_BAR) + args.li * XCD_BAR_WORDS, F.MISC + 8);
#endif


    if (lo <= 0 && 0 < hi) { phase_body<0>(F, args, ws, bar, hi, lds);
#if defined(DUP_PH) && DUP_PH == 0
        phase_body<0>(F, args, ws, bar, hi, lds);
#endif
    }
    if (lo <= 1 && 1 < hi) { phase_body<1>(F, args, ws, bar, hi, lds);
#if defined(DUP_PH) && DUP_PH == 1
        phase_body<1>(F, args, ws, bar, hi, lds);
#endif
    }
    if (lo <= 2 && 2 < hi) { phase_body<2>(F, args, ws, bar, hi, lds);
#if defined(DUP_PH) && DUP_PH == 2
        phase_body<2>(F, args, ws, bar, hi, lds);
#endif
    }
    if (lo <= 3 && 3 < hi) { phase_body<3>(F, args, ws, bar, hi, lds);
#if defined(DUP_PH) && DUP_PH == 3
        phase_body<3>(F, args, ws, bar, hi, lds);
#endif
    }
    if (lo <= 4 && 4 < hi) { phase_body<4>(F, args, ws, bar, hi, lds);
#if defined(DUP_PH) && DUP_PH == 4
        phase_body<4>(F, args, ws, bar, hi, lds);
#endif
    }
    if (lo <= 5 && 5 < hi) { phase_body<5>(F, args, ws, bar, hi, lds);
#if defined(DUP_PH) && DUP_PH == 5
        phase_body<5>(F, args, ws, bar, hi, lds);
#endif
    }
    if (lo <= 6 && 6 < hi) { phase_body<6>(F, args, ws, bar, hi, lds);
#if defined(DUP_PH) && DUP_PH == 6
        phase_body<6>(F, args, ws, bar, hi, lds);
#endif
#if defined(DUP_S5)
        phase_body<3>(F, args, ws, bar, hi, lds); phase_body<4>(F, args, ws, bar, hi, lds); phase_body<5>(F, args, ws, bar, hi, lds); phase_body<6>(F, args, ws, bar, hi, lds);
#endif
    }
    if (lo <= 7 && 7 < hi) { phase_body<7>(F, args, ws, bar, hi, lds);
#if defined(DUP_PH) && DUP_PH == 7
        phase_body<7>(F, args, ws, bar, hi, lds);
#endif
    }
    if (lo <= 8 && 8 < hi) { phase_body<8>(F, args, ws, bar, hi, lds);
#if defined(DUP_PH) && DUP_PH == 8
        phase_body<8>(F, args, ws, bar, hi, lds);
#endif
    }
    if (lo <= 9 && 9 < hi) { phase_body<9>(F, args, ws, bar, hi, lds);
#if defined(DUP_PH) && DUP_PH == 9
        phase_body<9>(F, args, ws, bar, hi, lds);
#endif
    }
    if (lo <= 10 && 10 < hi) { phase_body<10>(F, args, ws, bar, hi, lds);
#if defined(DUP_PH) && DUP_PH == 10
        phase_body<10>(F, args, ws, bar, hi, lds);
#endif
    }
    if (lo <= 11 && 11 < hi) { phase_body<11>(F, args, ws, bar, hi, lds);
#if defined(DUP_PH) && DUP_PH == 11
        phase_body<11>(F, args, ws, bar, hi, lds);
#endif
    }
    if (lo <= 12 && 12 < hi) { phase_body<12>(F, args, ws, bar, hi, lds);
#if defined(DUP_PH) && DUP_PH == 12
        phase_body<12>(F, args, ws, bar, hi, lds);
#endif
    }
    if (lo <= 13 && 13 < hi) { phase_body<13>(F, args, ws, bar, hi, lds);
#if defined(DUP_PH) && DUP_PH == 13
        phase_body<13>(F, args, ws, bar, hi, lds);
#endif
    }
    if (lo <= 14 && 14 < hi) { phase_body<14>(F, args, ws, bar, hi, lds);
#if defined(DUP_PH) && DUP_PH == 14
        phase_body<14>(F, args, ws, bar, hi, lds);
#endif
    }
    if (lo <= 15 && 15 < hi) { phase_body<15>(F, args, ws, bar, hi, lds);
#if defined(DUP_PH) && DUP_PH == 15
        phase_body<15>(F, args, ws, bar, hi, lds);
#endif
    }
    if (lo <= 16 && 16 < hi) { phase_body<16>(F, args, ws, bar, hi, lds);
#if defined(DUP_PH) && DUP_PH == 16
        phase_body<16>(F, args, ws, bar, hi, lds);
#endif
    }
    if (lo <= 17 && 17 < hi) { phase_body<17>(F, args, ws, bar, hi, lds);
#if defined(DUP_PH) && DUP_PH == 17
        phase_body<17>(F, args, ws, bar, hi, lds);
#endif
    }
    if (lo <= 18 && 18 < hi) { phase_body<18>(F, args, ws, bar, hi, lds);
#if defined(DUP_PH) && DUP_PH == 18
        phase_body<18>(F, args, ws, bar, hi, lds);
#endif
    }
    if (lo <= 19 && 19 < hi) { phase_body<19>(F, args, ws, bar, hi, lds);
#if defined(DUP_PH) && DUP_PH == 19
        phase_body<19>(F, args, ws, bar, hi, lds);
#endif
    }
    if (lo <= 20 && 20 < hi) { phase_body<20>(F, args, ws, bar, hi, lds);
#if defined(DUP_PH) && DUP_PH == 20
        phase_body<20>(F, args, ws, bar, hi, lds);
#endif
    }
#ifdef MK_SIMPLE_BAR
    if (hi - lo > 1) sb_end((unsigned*)F.ctl);
#endif
}

__global__ void __launch_bounds__(256) dg_cksum(const unsigned* p, size_t nwords, unsigned long long* out, int slot) {
    if (blockIdx.x == 0 && threadIdx.x == 0 && slot < 0) { out[0] = 0; out[1] = 0; }
    if (slot < 0) return;
    unsigned long long s = 0;
    for (size_t i = (size_t)blockIdx.x * 256 + threadIdx.x; i < nwords; i += (size_t)gridDim.x * 256) s += (unsigned long long)p[i] * (unsigned long long)(2 * (i & 0xffff) + 1);
    for (int o = 1; o < 64; o <<= 1) s += __shfl_xor(s, o);
    if ((threadIdx.x & 63) == 0) atomicAdd(out + slot, s);
}
__global__ void __launch_bounds__(256) dg_fill(unsigned* p, size_t nwords, unsigned pat) {
    for (size_t i = (size_t)blockIdx.x * 256 + threadIdx.x; i < nwords; i += (size_t)gridDim.x * 256) p[i] = pat;
}
__global__ void dg_cmp(const unsigned long long* c, unsigned* code) { if (threadIdx.x == 0) code[0] = (c[0] != c[1]) ? 1u : 0u; }
__global__ void __launch_bounds__(256) dg_nan_if(const unsigned long long* c, float* out, size_t n) {
    if (c[0] == c[1]) return;
    for (size_t i = (size_t)blockIdx.x * 256 + threadIdx.x; i < n; i += (size_t)gridDim.x * 256) out[i] = __builtin_nanf("");
}

extern "C" void kernel_launch(void* const* d_in, const int* in_sizes, int n_in, void* d_out, int out_size, void* d_ws, size_t ws_size, hipStream_t stream) {
    static int grid = 0;
    if (grid == 0) {
        if (n_in != 23 || in_sizes[0] != M * D || out_size != M * D || ws_size < WS_END) { fprintf(stderr, "kernel_launch: unexpected shapes / workspace (%d inputs, ws %zu)\n", n_in, ws_size); grid = -1; return; }
        int dev = 0, cus = 0;
        if (hipGetDevice(&dev) != hipSuccess || hipDeviceGetAttribute(&cus, hipDeviceAttributeMultiprocessorCount, dev) != hipSuccess) { grid = -1; return; }
        if (hipFuncSetAttribute((const void*)mk_fwd, hipFuncAttributeMaxDynamicSharedMemorySize, LDS_BYTES) != hipSuccess) { fprintf(stderr, "kernel_launch: hipFuncSetAttribute failed\n"); grid = -1; return; }
        int per_cu = 0;
        if (hipOccupancyMaxActiveBlocksPerMultiprocessor(&per_cu, (const void*)mk_fwd, NWAVES * 64, LDS_BYTES) != hipSuccess || per_cu < 1) fprintf(stderr, "kernel_launch: occupancy query says %d\n", per_cu);
        (void)hipGetLastError();
        grid = cus;
    }
    if (grid < 0) return;
    if (hipMemsetAsync((char*)d_ws + WS_CTL, 0, CTL_ZERO_BYTES, stream) != hipSuccess) return;
    Args a{};
    for (int i = 0; i < 23; ++i) a.in[i] = (const float*)d_in[i];
    a.out = (float*)d_out; a.ws = (unsigned char*)d_ws;
#if MK_MODE == 0
    a.ph_lo = 0; a.ph_hi = PH_N; a.li = 0;
    hipLaunchKernelGGL(mk_fwd, dim3(grid), dim3(NWAVES * 64), LDS_BYTES, stream, a);
#elif MK_MODE == 1
    for (int p = 0; p < PH_N; ++p) { a.ph_lo = p; a.ph_hi = p + 1; a.li = 0; hipLaunchKernelGGL(mk_fwd, dim3(grid), dim3(NWAVES * 64), LDS_BYTES, stream, a); }
#elif MK_MODE == 4
    unsigned long long* ck = (unsigned long long*)((char*)d_ws + WS_CTL + 512 * 1024);
    hipLaunchKernelGGL(dg_cksum, dim3(1), dim3(256), 0, stream, (const unsigned*)nullptr, (size_t)0, ck, -1);
    for (int pass = 0; pass < 2; ++pass) {
        hipLaunchKernelGGL(dg_fill, dim3(4096), dim3(256), 0, stream, (unsigned*)((char*)d_ws + 1 * MiB), (size_t)(WS_END - 1 * MiB) / 4, pass ? 0x33333333u : 0x55555555u);
        hipLaunchKernelGGL(dg_fill, dim3(4096), dim3(256), 0, stream, (unsigned*)d_out, (size_t)M * D, pass ? 0x77777777u : 0x11111111u);
        for (int p = 0; p < PH_N; ) {
            if (p == MK_CUT_LO) { a.ph_lo = MK_CUT_LO; a.ph_hi = MK_CUT_HI; p = MK_CUT_HI; } else { a.ph_lo = p; a.ph_hi = p + 1; ++p; }
            a.li = 0; hipLaunchKernelGGL(mk_fwd, dim3(grid), dim3(NWAVES * 64), LDS_BYTES, stream, a);
            if (a.ph_hi - a.ph_lo > 1) (void)hipMemsetAsync((char*)d_ws + WS_CTL + CW_BAR * 4, 0, XCD_BAR_WORDS * 4, stream);
        }
        hipLaunchKernelGGL(dg_cksum, dim3(1024), dim3(256), 0, stream, (const unsigned*)d_out, (size_t)M * D, ck, pass);
    }
    hipLaunchKernelGGL(dg_nan_if, dim3(1024), dim3(256), 0, stream, (const unsigned long long*)ck, (float*)d_out, (size_t)M * D);
#elif MK_MODE == 3
    unsigned long long* ck = (unsigned long long*)((char*)d_ws + WS_CTL + 512 * 1024);
    unsigned* code = (unsigned*)((char*)d_ws + WS_CTL) + CW_CODE;
    hipLaunchKernelGGL(dg_cksum, dim3(1), dim3(256), 0, stream, (const unsigned*)nullptr, (size_t)0, ck, -1);
    for (int p = MK_CUT_LO; p < MK_CUT_HI; ++p) { a.ph_lo = p; a.ph_hi = p + 1; hipLaunchKernelGGL(mk_fwd, dim3(grid), dim3(NWAVES * 64), LDS_BYTES, stream, a); }
    hipLaunchKernelGGL(dg_cksum, dim3(1024), dim3(256), 0, stream, (const unsigned*)((char*)d_ws + WS_ACT), (size_t)M * FF / 2, ck, 0);
#if defined(DG_SCRAMBLE) && DG_SCRAMBLE == 1
    hipLaunchKernelGGL(dg_fill, dim3(2048), dim3(256), 0, stream, (unsigned*)((char*)d_ws + WS_XB), (size_t)M * D / 2, 0x3f803f80u);
#elif defined(DG_SCRAMBLE) && DG_SCRAMBLE == 2
    hipLaunchKernelGGL(dg_fill, dim3(2048), dim3(256), 0, stream, (unsigned*)((char*)d_ws + WS_WIN), (size_t)2 * FF * D / 2, 0x3c003c00u);
#elif defined(DG_SCRAMBLE) && DG_SCRAMBLE == 3
    hipLaunchKernelGGL(dg_fill, dim3(64), dim3(256), 0, stream, (unsigned*)((char*)d_ws + WS_RSS), (size_t)M, 0x44800000u);
#endif
    a.ph_lo = MK_CUT_LO; a.ph_hi = MK_CUT_HI; hipLaunchKernelGGL(mk_fwd, dim3(grid), dim3(NWAVES * 64), LDS_BYTES, stream, a);
    hipLaunchKernelGGL(dg_cksum, dim3(1024), dim3(256), 0, stream, (const unsigned*)((char*)d_ws + WS_ACT), (size_t)M * FF / 2, ck, 1);
    hipLaunchKernelGGL(dg_cmp, dim3(1), dim3(64), 0, stream, (const unsigned long long*)ck, code);
    for (int p = MK_CUT_HI; p < PH_N; ++p) { a.ph_lo = p; a.ph_hi = p + 1; hipLaunchKernelGGL(mk_fwd, dim3(grid), dim3(NWAVES * 64), LDS_BYTES, stream, a); }
#else
    for (int p = 0; p < PH_N; ) {
        if (p == MK_CUT_LO) { a.ph_lo = MK_CUT_LO; a.ph_hi = MK_CUT_HI; p = MK_CUT_HI; } else { a.ph_lo = p; a.ph_hi = p + 1; ++p; }
        a.li = 0; hipLaunchKernelGGL(mk_fwd, dim3(grid), dim3(NWAVES * 64), LDS_BYTES, stream, a);
        if (a.ph_hi - a.ph_lo > 1 && p < PH_N) (void)hipMemsetAsync((char*)d_ws + WS_CTL + CW_BAR * 4, 0, XCD_BAR_WORDS * 4, stream);
    }
#endif
}
```
